# Optimizing an MI355X kernel written in HIP

```python
import math
import jax
import jax.numpy as jnp
from jax import lax
import numpy as np

D_MODEL = 2048
BATCH = 4
SEQ = 4096
DEPTH = 2

GRID_W = 64
CTX_LEN = 256
HEAD_DIM = 64
Q_BLOCK = 128
ROPE_THETA = 10000.0
EPS = 1e-6
A_HEADS = 4
A_QK_DIM = 64
A_V_DIM = 128
B_HEADS = 8
B_KV_HEADS = 2
C_HEADS = 8
C_Q_RANK = 768
C_KV_RANK = 256
C_NOPE_DIM = 64
C_ROPE_DIM = 32
C_V_DIM = 64
D_HEADS = 8
D_KV_HEADS = 2
WINDOW = 128
A_Q_COLS = 2 * A_HEADS * A_QK_DIM
B_Q_COLS = B_HEADS * HEAD_DIM
C_Q_COLS = C_Q_RANK
D_Q_COLS = D_HEADS * HEAD_DIM
A_KV_COLS = 2 * A_HEADS * A_QK_DIM + A_HEADS * A_V_DIM
B_KV_COLS = 2 * B_KV_HEADS * HEAD_DIM
C_KV_COLS = C_KV_RANK + C_ROPE_DIM
D_KV_COLS = 2 * D_KV_HEADS * HEAD_DIM
Q_SIZES = (A_Q_COLS, B_Q_COLS, C_Q_COLS, D_Q_COLS)
KV_SIZES = (A_KV_COLS, B_KV_COLS, C_KV_COLS, D_KV_COLS)
Q_COLS = A_Q_COLS + B_Q_COLS + C_Q_COLS + D_Q_COLS
KV_COLS = A_KV_COLS + B_KV_COLS + C_KV_COLS + D_KV_COLS
IN_COLS = Q_COLS + KV_COLS
MIX_WIDTH = A_HEADS * A_V_DIM + B_HEADS * HEAD_DIM + C_HEADS * C_V_DIM + D_HEADS * HEAD_DIM
D_FF = 5632
N_EXPERTS = 8
TOP_K = 2
EXPERT_FF = 5632
N_DENSE = (DEPTH + 1) // 2
N_MOE = DEPTH // 2

kernel_name = 'hybrid_parallel_heads_flow_block'


def rms_norm(x, g):
    xf = x.astype(jnp.float32)
    y = xf * lax.rsqrt(jnp.mean(xf * xf, axis=-1, keepdims=True) + EPS)
    return (y * g.astype(jnp.float32)).astype(x.dtype)


def split_cols(t, sizes):
    out = []
    o = 0
    for s in sizes:
        out.append(t[..., o:o + s])
        o += s
    return out


def split_heads(t, n, d):
    return t.reshape(t.shape[0], t.shape[1], n, d)


def merge_heads(o):
    return o.reshape(o.shape[0], o.shape[1], -1)


def rope_tables(rows, cols, rot_dim):
    axis_dim = rot_dim // 2
    inv = ROPE_THETA ** (-jnp.arange(0, axis_dim, 2, dtype=jnp.float32) / axis_dim)
    ar = rows.astype(jnp.float32)[:, None] * inv[None, :]
    ac = cols.astype(jnp.float32)[:, None] * inv[None, :]
    return (jnp.cos(ar), jnp.sin(ar), jnp.cos(ac), jnp.sin(ac))


def _rotate(x, cos, sin):
    n = x.shape[-1] // 2
    x1, x2 = x[..., :n], x[..., n:]
    return jnp.concatenate([x1 * cos - x2 * sin, x2 * cos + x1 * sin], axis=-1)


def apply_rope2d(x, tables):
    shape = (x.shape[1],) + (1,) * (x.ndim - 3) + (tables[0].shape[-1],)
    cr, sr, cc, sc = (t.reshape(shape).astype(x.dtype) for t in tables)
    half = x.shape[-1] // 2
    return jnp.concatenate([_rotate(x[..., :half], cr, sr), _rotate(x[..., half:], cc, sc)], axis=-1)


def _attend_block(q, k, v, scale, sink=None, mask=None):
    s = jnp.einsum('bqgrd,bkgd->bgrqk', q, k).astype(jnp.float32) * scale
    if mask is not None:
        s = jnp.where(mask, s, -jnp.inf)
    if sink is not None:
        g, r = q.shape[2], q.shape[3]
        sk = jnp.broadcast_to(sink.astype(jnp.float32).reshape(1, g, r, 1, 1), s.shape[:-1] + (1,))
        p = jax.nn.softmax(jnp.concatenate([s, sk], axis=-1), axis=-1)[..., :-1]
    else:
        p = jax.nn.softmax(s, axis=-1)
    return jnp.einsum('bgrqk,bkgd->bqgrd', p.astype(v.dtype), v)


def dense_attention(q, k, v, scale, sink=None):
    bsz, sq, n_heads, dk = q.shape
    g = k.shape[2]
    r = n_heads // g
    nb = sq // Q_BLOCK
    qb = q.reshape(bsz, nb, Q_BLOCK, g, r, dk).swapaxes(0, 1)
    o = lax.map(lambda qi: _attend_block(qi, k, v, scale, sink), qb)
    return o.swapaxes(0, 1).reshape(bsz, sq, n_heads, v.shape[-1])


def window_attention(q, k, v, k_ctx, v_ctx, scale, sink):
    bsz, s_len, n_heads, dk = q.shape
    g = k.shape[2]
    r = n_heads // g
    nb = s_len // Q_BLOCK
    wb = WINDOW // Q_BLOCK
    band_len = (2 * wb + 1) * Q_BLOCK

    def band(t):
        tp = jnp.pad(t, ((0, 0), (WINDOW, WINDOW), (0, 0), (0, 0)))
        tb = tp.reshape(bsz, nb + 2 * wb, Q_BLOCK, g, t.shape[-1])
        return jnp.concatenate([tb[:, j:j + nb] for j in range(2 * wb + 1)], axis=2).swapaxes(0, 1)

    blk = jnp.arange(nb)[:, None, None]
    qpos = blk * Q_BLOCK + jnp.arange(Q_BLOCK)[None, :, None]
    kpos = blk * Q_BLOCK - WINDOW + jnp.arange(band_len)[None, None, :]
    band_mask = (jnp.abs(qpos - kpos) <= WINDOW) & (kpos >= 0) & (kpos < s_len)
    mask = jnp.concatenate([band_mask, jnp.ones((nb, Q_BLOCK, k_ctx.shape[1]), dtype=bool)], axis=-1)
    qb = q.reshape(bsz, nb, Q_BLOCK, g, r, dk).swapaxes(0, 1)

    def one(args):
        qi, ki, vi, mi = args
        return _attend_block(qi, jnp.concatenate([ki, k_ctx], axis=1), jnp.concatenate([vi, v_ctx], axis=1), scale, sink, mi)

    o = lax.map(one, (qb, band(k), band(v), mask))
    return o.swapaxes(0, 1).reshape(bsz, s_len, n_heads, v.shape[-1])


def diff_attention_mixer(q_lat, kv_lat, q_ctx, kv_ctx, lam_q1, lam_k1, lam_q2, lam_k2, subln, lam_init, rope):
    nk = 2 * A_HEADS * A_QK_DIM

    def qk(t):
        return t.reshape(t.shape[0], t.shape[1], 2, A_HEADS, A_QK_DIM)

    def vals(t):
        return split_heads(t, A_HEADS, A_V_DIM)

    q = apply_rope2d(qk(q_lat), rope)
    k = apply_rope2d(qk(kv_lat[..., :nk]), rope)
    v = vals(kv_lat[..., nk:])
    k_c, v_c = qk(kv_ctx[..., :nk]), vals(kv_ctx[..., nk:])
    k_all = jnp.concatenate([k_c, k], axis=1)
    v_all = jnp.concatenate([v_c, v], axis=1)
    lam = (jnp.exp(jnp.sum(lam_q1.astype(jnp.float32) * lam_k1.astype(jnp.float32)))
           - jnp.exp(jnp.sum(lam_q2.astype(jnp.float32) * lam_k2.astype(jnp.float32))) + lam_init)
    scale = A_QK_DIM ** -0.5

    def diff(qq, kk, vv):
        a1 = dense_attention(qq[:, :, 0], kk[:, :, 0], vv, scale)
        a2 = dense_attention(qq[:, :, 1], kk[:, :, 1], vv, scale)
        o = rms_norm(a1 - lam.astype(a1.dtype) * a2, subln) * (1.0 - lam_init)
        return merge_heads(o)

    o_lat = diff(q, k_all, v_all)
    o_ctx = None if q_ctx is None else diff(qk(q_ctx), k_c, v_c)
    return o_lat, o_ctx


def qknorm_gqa_mixer(q_lat, kv_lat, q_ctx, kv_ctx, q_norm, k_norm, rope):
    nk = B_KV_HEADS * HEAD_DIM

    def qproj(t):
        return rms_norm(split_heads(t, B_HEADS, HEAD_DIM), q_norm)

    def kproj(t):
        return rms_norm(split_heads(t[..., :nk], B_KV_HEADS, HEAD_DIM), k_norm)

    def vproj(t):
        return split_heads(t[..., nk:], B_KV_HEADS, HEAD_DIM)

    q = apply_rope2d(qproj(q_lat), rope)
    k = apply_rope2d(kproj(kv_lat), rope)
    v = vproj(kv_lat)
    k_c, v_c = kproj(kv_ctx), vproj(kv_ctx)
    scale = HEAD_DIM ** -0.5
    o_lat = dense_attention(q, jnp.concatenate([k_c, k], axis=1), jnp.concatenate([v_c, v], axis=1), scale)
    o_ctx = None if q_ctx is None else merge_heads(dense_attention(qproj(q_ctx), k_c, v_c, scale))
    return merge_heads(o_lat), o_ctx


def mla_mixer(q_lat, kv_lat, q_ctx, kv_ctx, q_norm, kv_norm, w_q_up, w_kv_up, rope):
    def qproj(t):
        qf = split_heads(rms_norm(t, q_norm) @ w_q_up, C_HEADS, C_NOPE_DIM + C_ROPE_DIM)
        return qf[..., :C_NOPE_DIM], qf[..., C_NOPE_DIM:]

    def kvproj(t):
        c_kv, k_rope = t[..., :C_KV_RANK], t[..., C_KV_RANK:]
        kv = split_heads(rms_norm(c_kv, kv_norm) @ w_kv_up, C_HEADS, C_NOPE_DIM + C_V_DIM)
        return kv[..., :C_NOPE_DIM], k_rope[:, :, None, :], kv[..., C_NOPE_DIM:]

    def join(nope, rope_part):
        return jnp.concatenate([nope, jnp.broadcast_to(rope_part, nope.shape[:-1] + (C_ROPE_DIM,))], axis=-1)

    qn, qr = qproj(q_lat)
    q = join(qn, apply_rope2d(qr, rope))
    kn, kr, v = kvproj(kv_lat)
    k = join(kn, apply_rope2d(kr, rope))
    kn_c, kr_c, v_c = kvproj(kv_ctx)
    k_c = join(kn_c, kr_c)
    scale = (C_NOPE_DIM + C_ROPE_DIM) ** -0.5
    o_lat = dense_attention(q, jnp.concatenate([k_c, k], axis=1), jnp.concatenate([v_c, v], axis=1), scale)
    if q_ctx is None:
        o_ctx = None
    else:
        qn_c, qr_c = qproj(q_ctx)
        o_ctx = merge_heads(dense_attention(join(qn_c, qr_c), k_c, v_c, scale))
    return merge_heads(o_lat), o_ctx


def window_sink_mixer(q_lat, kv_lat, q_ctx, kv_ctx, sink, rope):
    nk = D_KV_HEADS * HEAD_DIM
    q = apply_rope2d(split_heads(q_lat, D_HEADS, HEAD_DIM), rope)
    k = apply_rope2d(split_heads(kv_lat[..., :nk], D_KV_HEADS, HEAD_DIM), rope)
    v = split_heads(kv_lat[..., nk:], D_KV_HEADS, HEAD_DIM)
    k_c = split_heads(kv_ctx[..., :nk], D_KV_HEADS, HEAD_DIM)
    v_c = split_heads(kv_ctx[..., nk:], D_KV_HEADS, HEAD_DIM)
    scale = HEAD_DIM ** -0.5
    o_lat = window_attention(q, k, v, k_c, v_c, scale, sink)
    o_ctx = None if q_ctx is None else merge_heads(dense_attention(split_heads(q_ctx, D_HEADS, HEAD_DIM), k_c, v_c, scale, sink))
    return merge_heads(o_lat), o_ctx


def swiglu(u, w_gate, w_up, w_down):
    return (jax.nn.silu(u @ w_gate) * (u @ w_up)) @ w_down


def moe_swiglu(u, w_router, b_router, w_gate, w_up, w_down):
    logits = (u @ w_router + b_router).astype(jnp.float32)
    top_val, top_idx = lax.top_k(logits, TOP_K)
    top_w = jax.nn.softmax(top_val, axis=-1)
    gates = jnp.sum(jax.nn.one_hot(top_idx, N_EXPERTS, dtype=jnp.float32) * top_w[..., None], axis=-2)
    out = jnp.zeros_like(u)
    for e in range(N_EXPERTS):
        out = out + gates[..., e:e + 1].astype(u.dtype) * swiglu(u, w_gate[e], w_up[e], w_down[e])
    return out


def setup_inputs(seed: int = 0) -> dict:
    key = jax.random.key(seed)
    ks = iter(jax.random.split(key, 40))

    def nrm(shape, scale):
        return jax.random.normal(next(ks), shape, jnp.float32) * scale

    def gain(shape):
        return 1.0 + nrm(shape, 0.02)

    d = D_MODEL
    return {
        'x': nrm((BATCH, SEQ, d), 1.0),
        'c': nrm((BATCH, d), 1.0),
        'ctx': nrm((BATCH, CTX_LEN, d), 1.0),
        'c_ctx': nrm((d,), 1.0),
        'w_mod': nrm((DEPTH, d, 6 * d), 0.5 * d ** -0.5),
        'b_mod': nrm((DEPTH, 6 * d), 0.02),
        'g_mix': gain((DEPTH, d)),
        'g_ffn': gain((DEPTH, d)),
        'g_final': gain((d,)),
        'w_in': nrm((DEPTH, d, IN_COLS), d ** -0.5),
        'w_out': nrm((DEPTH, MIX_WIDTH, d), MIX_WIDTH ** -0.5),
        'a_lam_q1': nrm((DEPTH, A_QK_DIM), 0.1),
        'a_lam_k1': nrm((DEPTH, A_QK_DIM), 0.1),
        'a_lam_q2': nrm((DEPTH, A_QK_DIM), 0.1),
        'a_lam_k2': nrm((DEPTH, A_QK_DIM), 0.1),
        'a_subln': gain((DEPTH, A_V_DIM)),
        'b_q_norm': gain((DEPTH, HEAD_DIM)),
        'b_k_norm': gain((DEPTH, HEAD_DIM)),
        'c_q_norm': gain((DEPTH, C_Q_RANK)),
        'c_kv_norm': gain((DEPTH, C_KV_RANK)),
        'c_w_q_up': nrm((DEPTH, C_Q_RANK, C_HEADS * (C_NOPE_DIM + C_ROPE_DIM)), C_Q_RANK ** -0.5),
        'c_w_kv_up': nrm((DEPTH, C_KV_RANK, C_HEADS * (C_NOPE_DIM + C_V_DIM)), C_KV_RANK ** -0.5),
        'd_sink': nrm((DEPTH, D_HEADS), 0.5),
        'ffn_w_gate': nrm((N_DENSE, d, D_FF), d ** -0.5),
        'ffn_w_up': nrm((N_DENSE, d, D_FF), d ** -0.5),
        'ffn_w_down': nrm((N_DENSE, D_FF, d), D_FF ** -0.5),
        'moe_w_router': nrm((N_MOE, d, N_EXPERTS), d ** -0.5),
        'moe_b_router': nrm((N_MOE, N_EXPERTS), 0.01),
        'moe_w_gate': nrm((N_MOE, N_EXPERTS, d, EXPERT_FF), d ** -0.5),
        'moe_w_up': nrm((N_MOE, N_EXPERTS, d, EXPERT_FF), d ** -0.5),
        'moe_w_down': nrm((N_MOE, N_EXPERTS, EXPERT_FF, d), EXPERT_FF ** -0.5),
    }


def reference(x, c, ctx, c_ctx, w_mod, b_mod, g_mix, g_ffn, g_final, w_in, w_out,
              a_lam_q1, a_lam_k1, a_lam_q2, a_lam_k2, a_subln, b_q_norm, b_k_norm,
              c_q_norm, c_kv_norm, c_w_q_up, c_w_kv_up, d_sink,
              ffn_w_gate, ffn_w_up, ffn_w_down,
              moe_w_router, moe_b_router, moe_w_gate, moe_w_up, moe_w_down):
    n_tok = x.shape[1]
    n_rows = n_tok // GRID_W
    t = jnp.arange(n_rows * GRID_W)
    rows, cols = t // GRID_W, t % GRID_W
    rope_head = rope_tables(rows, cols, HEAD_DIM)
    rope_mla = rope_tables(rows, cols, C_ROPE_DIM)

    def ffn(l, u):
        i = l // 2
        if l % 2 == 0:
            return swiglu(u, ffn_w_gate[i], ffn_w_up[i], ffn_w_down[i])
        return moe_swiglu(u, moe_w_router[i], moe_b_router[i], moe_w_gate[i], moe_w_up[i], moe_w_down[i])

    h_lat = x
    h_ctx = ctx
    for l in range(DEPTH):
        last = l == DEPTH - 1
        lam_init = 0.8 - 0.6 * math.exp(-0.3 * l)
        n_ctx_mod = 2 * D_MODEL if last else 6 * D_MODEL
        m_lat = (jax.nn.silu(c) @ w_mod[l] + b_mod[l])[:, None, :]
        m_ctx = (jax.nn.silu(c_ctx) @ w_mod[l][:, :n_ctx_mod] + b_mod[l][:n_ctx_mod])[None, None, :]
        sh1, sc1, gt1, sh2, sc2, gt2 = jnp.split(m_lat, 6, axis=-1)
        cm = jnp.split(m_ctx, n_ctx_mod // D_MODEL, axis=-1)

        u_lat = rms_norm(h_lat, g_mix[l]) * (1 + sc1) + sh1
        u_ctx = rms_norm(h_ctx, g_mix[l]) * (1 + cm[1]) + cm[0]
        p_lat = u_lat @ w_in[l]
        qs_lat = split_cols(p_lat[..., :Q_COLS], Q_SIZES)
        kvs_lat = split_cols(p_lat[..., Q_COLS:], KV_SIZES)
        if last:
            qs_ctx = [None, None, None, None]
            kvs_ctx = split_cols(u_ctx @ w_in[l][:, Q_COLS:], KV_SIZES)
        else:
            p_ctx = u_ctx @ w_in[l]
            qs_ctx = split_cols(p_ctx[..., :Q_COLS], Q_SIZES)
            kvs_ctx = split_cols(p_ctx[..., Q_COLS:], KV_SIZES)

        oa, oa_c = diff_attention_mixer(qs_lat[0], kvs_lat[0], qs_ctx[0], kvs_ctx[0],
                                        a_lam_q1[l], a_lam_k1[l], a_lam_q2[l], a_lam_k2[l], a_subln[l], lam_init, rope_head)
        ob, ob_c = qknorm_gqa_mixer(qs_lat[1], kvs_lat[1], qs_ctx[1], kvs_ctx[1], b_q_norm[l], b_k_norm[l], rope_head)
        oc, oc_c = mla_mixer(qs_lat[2], kvs_lat[2], qs_ctx[2], kvs_ctx[2],
                             c_q_norm[l], c_kv_norm[l], c_w_q_up[l], c_w_kv_up[l], rope_mla)
        od, od_c = window_sink_mixer(qs_lat[3], kvs_lat[3], qs_ctx[3], kvs_ctx[3], d_sink[l], rope_head)

        h_lat = h_lat + gt1 * (jnp.concatenate([oa, ob, oc, od], axis=-1) @ w_out[l])
        if not last:
            h_ctx = h_ctx + cm[2] * (jnp.concatenate([oa_c, ob_c, oc_c, od_c], axis=-1) @ w_out[l])

        h_lat = h_lat + gt2 * ffn(l, rms_norm(h_lat, g_ffn[l]) * (1 + sc2) + sh2)
        if not last:
            h_ctx = h_ctx + cm[5] * ffn(l, rms_norm(h_ctx, g_ffn[l]) * (1 + cm[4]) + cm[3])

    return rms_norm(h_lat, g_final)
```

```cpp
#include <hip/hip_runtime.h>
#include <cstdint>
#include <cstdio>

#define GAS __attribute__((address_space(1)))
#define LAS __attribute__((address_space(3)))
#define PG8_LAS LAS
typedef unsigned short bf16_t;
typedef short bf16x8 __attribute__((ext_vector_type(8)));
typedef float f32x4 __attribute__((ext_vector_type(4)));
typedef float f32x2 __attribute__((ext_vector_type(2)));
typedef float f32x16 __attribute__((ext_vector_type(16)));
typedef unsigned u32x4 __attribute__((ext_vector_type(4)));
typedef unsigned u32x2 __attribute__((ext_vector_type(2)));
typedef __bf16 bf16x2_t __attribute__((ext_vector_type(2)));
typedef GAS unsigned gu32;

constexpr int DM = 2048, NBATCH = 4, SEQ = 4096, CTXL = 256;
constexpr int SK = SEQ + CTXL;
constexpr int MR = NBATCH * SK;
constexpr int NPANEL = MR / 256;
constexpr int IN_SRC = 4128;
constexpr int INW = 4352;
constexpr int PW = 3584;
constexpr int FF = 5632, NEXP = 8, NGU_T = 44;
constexpr int VT_ROWS = 1280;
constexpr int RS_MAX = 34816;
constexpr int NLAT = NBATCH * SEQ;
constexpr float EPS = 1e-6f;
constexpr float LOG2E = 1.4426950408889634f;
constexpr float QS64 = 0.125f * LOG2E;
constexpr float QS96 = 0.10206207261596575f * LOG2E;

constexpr size_t MiB = 1u << 20;
constexpr size_t WS_CTL = 0, CTL_ZERO_BYTES = 1 * MiB;
constexpr size_t WS_CONST = 1 * MiB;
constexpr size_t WS_ROUTE = 2 * MiB;
constexpr size_t WS_WIN = 3 * MiB;
constexpr size_t WS_WOUT = WS_WIN + 34 * MiB;
constexpr size_t WS_WQUP = WS_WOUT + 16 * MiB;
constexpr size_t WS_WKVUP = WS_WQUP + 3 * MiB;
constexpr size_t WS_WGU0 = WS_WKVUP + 1 * MiB;
constexpr size_t WS_WDN0 = WS_WGU0 + 44 * MiB;
constexpr size_t WS_WGU1 = WS_WDN0 + 22 * MiB;
constexpr size_t WS_WDN1 = WS_WGU1 + 352 * MiB;
constexpr size_t WS_H = WS_WDN1 + 176 * MiB;
constexpr size_t WS_U = WS_H + 136 * MiB;
constexpr size_t WS_Z = WS_U + 68 * MiB;
constexpr size_t WS_P = WS_Z;
constexpr size_t WS_VT = WS_P + 119 * MiB;
constexpr size_t WS_KC = WS_VT + 43 * MiB;
constexpr size_t WS_QC = WS_KC + 26 * MiB;
constexpr size_t WS_O = WS_QC + 26 * MiB;
constexpr size_t WS_U2S = WS_Z;
constexpr size_t WS_Y = WS_Z + 136 * MiB;
constexpr size_t WS_ACT = WS_Z + 282 * MiB;
constexpr size_t WS_END = WS_ACT + 374 * MiB;
static_assert(WS_O + (size_t)MR * DM * 2 <= WS_ACT && WS_Y + (size_t)RS_MAX * DM * 2 <= WS_ACT, "region Z");
static_assert((size_t)RS_MAX * FF * 2 <= 374 * MiB && (size_t)MR * PW * 2 <= 119 * MiB && (size_t)NBATCH * VT_ROWS * SK * 2 <= 43 * MiB, "sizes");
static_assert((size_t)2 * INW * DM * 2 <= 34 * MiB && (size_t)8 * 11264 * 2048 * 2 <= 352 * MiB && (size_t)8 * 2048 * 5632 * 2 <= 176 * MiB, "weights");

constexpr int CO_MOD = 0;
constexpr int CO_ROPEH = 2 * 5 * 12288;
constexpr int CO_ROPEM = CO_ROPEH + 2048;
constexpr int CO_LAM = CO_ROPEM + 1024;
constexpr int RO_E = 0, RO_SLOT = 2 * NLAT, RO_GATE = 4 * NLAT, RO_POS = 6 * NLAT;
static_assert((size_t)8 * NLAT * 4 <= 1 * MiB, "route");
constexpr int CW_TMO = 0, CW_CODE = 1, CW_BAR = 4096, CW_MOE = 16384;

constexpr int RING_BYTES = 131072;
constexpr int LDSCTL_OFF = RING_BYTES, MISC_OFF = LDSCTL_OFF + 320;
constexpr int LDS_BYTES = 147456;

__device__ __forceinline__ unsigned pk2(float lo, float hi) { f32x2 v = {lo, hi}; bf16x2_t b = __builtin_convertvector(v, bf16x2_t); return __builtin_bit_cast(unsigned, b); }
__device__ __forceinline__ float bflo(unsigned w) { return __uint_as_float(w << 16); }
__device__ __forceinline__ float bfhi(unsigned w) { return __uint_as_float(w & 0xffff0000u); }
__device__ __forceinline__ float shfl_xor_l(float v, int mask, int lane) { return __int_as_float(__builtin_amdgcn_ds_bpermute((lane ^ mask) << 2, __float_as_int(v))); }
__device__ __forceinline__ float wave_sum(float v, int lane) {
#pragma unroll
    for (int o = 1; o < 64; o <<= 1) v += shfl_xor_l(v, o, lane);
    return v;
}
__device__ __forceinline__ float xsum32(float a) { auto rr = __builtin_amdgcn_permlane32_swap(__float_as_uint(a), __float_as_uint(a), false, false); return __uint_as_float(rr[0]) + __uint_as_float(rr[1]); }
__device__ __forceinline__ float xmax32(float a) { auto rr = __builtin_amdgcn_permlane32_swap(__float_as_uint(a), __float_as_uint(a), false, false); return fmaxf(__uint_as_float(rr[0]), __uint_as_float(rr[1])); }
__device__ __forceinline__ float silu_f(float x) { return x * __builtin_amdgcn_rcpf(1.0f + __builtin_amdgcn_exp2f(-x * LOG2E)); }
__device__ __forceinline__ unsigned char* opaque_ws(unsigned char* p) { asm volatile("" : "+s"(p)); return p; }
__device__ __forceinline__ int opaque_tid() { int t = threadIdx.x; asm volatile("" : "+v"(t)); return t; }
#define LDS_WAIT() asm volatile("s_waitcnt lgkmcnt(0)" ::: "memory")

namespace pg8 {
constexpr int BM = 256, BK = 64, HALF = 128, HTB = HALF * BK * 2, STAGE_BYTES = 8 * HTB, NXCD = 8, WGM = 8;
__host__ __device__ __forceinline__ int lds_byte(int r, int c) { const int st = (r >> 4) * 2 + (c >> 5), rr = r & 15, cc = c & 31, ob = rr * 64 + cc * 2; return st * 1024 + (ob ^ (((ob >> 9) & 1) << 5)); }
__host__ __device__ __forceinline__ void stage_rc(int b, int& R, int& C) { const int st = b / 1024, sb = b % 1024, swz = sb ^ (((sb >> 9) & 1) << 5); R = (st >> 1) * 16 + swz / 64; C = (st & 1) * 32 + (swz % 64) / 2; }
__host__ __device__ __forceinline__ int perm32(int rho) { const int n = rho >> 4, i = rho & 15; return 8 * (i >> 2) + 4 * n + (i & 3); }

struct Unit { int pm, pn, pb; };
struct Gemm { const bf16_t* A; const bf16_t* Bt; int lda, K; };

struct Sched {
    int nM, nN, nwg, G, c, pmode; const LAS int* epan;
    __device__ __forceinline__ void init(int nM_, int nN_, int G_, int c_, int pmode_, const LAS int* epan_) { nM = nM_; nN = nN_; nwg = nM * nN; G = G_; c = c_; pmode = pmode_; epan = epan_; }
    __device__ __forceinline__ bool next(int i, Unit& u) const {
        const long L = (long)i * G + c; if (L >= nwg) return false;
        int wgid = (int)L; { const int q = nwg / NXCD, r = nwg % NXCD, xcd = wgid % NXCD, off = wgid / NXCD; wgid = (xcd < r ? xcd * (q + 1) : r * (q + 1) + (xcd - r) * q) + off; }
        const int nig = WGM * nN, gid = wgid / nig, fm = gid * WGM, gsz = (nM - fm) < WGM ? (nM - fm) : WGM;
        int pm = fm + ((wgid % nig) % gsz); const int pn = (wgid % nig) / gsz;
        u.pn = pn; u.pb = pn;
        if (epan) { int e = 0;
#pragma unroll
            for (int j = 1; j < 8; ++j) e += (pm >= epan[j]) ? 1 : 0;
            u.pb = e * nN + pn; }
        if (pmode == 1) pm = pm + pm / 16 + 1;
        u.pm = pm; return true;
    }
    __device__ __forceinline__ void a_ready(const Unit&) const {}
    __device__ __forceinline__ void done(const Unit&) const {}
};

template <class Epi, class Sched, bool ALIGN_EPI = false, bool SP2 = false>
__device__ __forceinline__ void gemm_phase(PG8_LAS unsigned char* lds, const Gemm g, const Sched& S, const Epi& E) {
    const int tid = opaque_tid(), wid = __builtin_amdgcn_readfirstlane(tid >> 6), lane = tid & 63, wr = wid >> 2, wc = wid & 3, fr = lane & 15, fq = lane >> 4;
    const int K = g.K, nt = K / BK;
    unsigned voffA[2], voffB[2];
#pragma unroll
    for (int i = 0; i < 2; ++i) { int R, C; stage_rc(tid * 16 + i * 8192, R, C); const int Rb = Epi::PERM ? ((R & ~31) + perm32(R & 31)) : R;
        voffA[i] = (unsigned)(R * g.lda + C) * 2u; voffB[i] = (unsigned)(Rb * K + C) * 2u; }
    const size_t kstep = (size_t)(BK * 2);
    const size_t hstepA = (size_t)HALF * g.lda * 2, hstepB = (size_t)HALF * K * 2;
    const size_t tstepA = 2 * hstepA, tstepB = 2 * hstepB;
    const unsigned ldsw = (unsigned)wid * 1024u;
    const int aoff = lds_byte(wr * 64 + fr, fq * 8), boff = lds_byte(wc * 32 + fr, fq * 8);
#define PG8_SA(b, h) (((b) * 2 + (h)) * HTB)
#define PG8_SB(b, h) ((4 + (b) * 2 + (h)) * HTB)
#define PG8_STAGE(bufoff, gbase, voff) do { _Pragma("unroll") for (int _i = 0; _i < 2; ++_i) \
        __builtin_amdgcn_global_load_lds((const unsigned*)((const char*)(gbase) + (voff)[_i]), (PG8_LAS unsigned*)(lds + (bufoff) + ldsw + _i * 8192), 16, 0, 0); } while (0)
#define PG8_LDA(dst, b, h) do { _Pragma("unroll") for (int m = 0; m < 4; ++m) _Pragma("unroll") for (int k = 0; k < 2; ++k) dst[m][k] = *(const PG8_LAS bf16x8*)(lds + PG8_SA(b, h) + aoff + m * 2048 + k * 1024); } while (0)
#define PG8_LDB(dst, b, h) do { _Pragma("unroll") for (int n = 0; n < 2; ++n) _Pragma("unroll") for (int k = 0; k < 2; ++k) dst[n][k] = *(const PG8_LAS bf16x8*)(lds + PG8_SB(b, h) + boff + n * 2048 + k * 1024); } while (0)
#define PG8_MMA(ai, bj, At, Bt) do { __builtin_amdgcn_s_setprio(1); _Pragma("unroll") for (int m = 0; m < 4; ++m) _Pragma("unroll") for (int n = 0; n < 2; ++n) _Pragma("unroll") for (int k = 0; k < 2; ++k) \
        acc[ai][bj][m][n] = __builtin_amdgcn_mfma_f32_16x16x32_bf16(Bt[n][k], At[m][k], acc[ai][bj][m][n], 0, 0, 0); __builtin_amdgcn_s_setprio(0); } while (0)
#define PG8_WAIT_V(n) asm volatile("s_waitcnt vmcnt(" #n ")" ::: "memory")
#define PG8_WAIT_L(n) asm volatile("s_waitcnt lgkmcnt(" #n ")" ::: "memory")
#define PG8_BAR __builtin_amdgcn_s_barrier()
#define PG8_SCHED __builtin_amdgcn_sched_barrier(0)
    Unit cur, nxt; int ui = 0;
    if (!S.next(0, cur)) return;
    f32x4 acc[2][2][4][2];
#pragma unroll
    for (int a = 0; a < 2; ++a)
#pragma unroll
        for (int b = 0; b < 2; ++b)
#pragma unroll
            for (int m = 0; m < 4; ++m)
#pragma unroll
                for (int n = 0; n < 2; ++n) acc[a][b][m][n] = (f32x4){0.f, 0.f, 0.f, 0.f};
    bf16x8 At[4][2], B0[2][2], B1[2][2];
    const char* cA = (const char*)g.A + (size_t)cur.pm * tstepA; const char* cB = (const char*)g.Bt + (size_t)cur.pb * tstepB;
    S.a_ready(cur);
    if constexpr (SP2) {
        PG8_STAGE(PG8_SB(0, 0), cB, voffB); PG8_STAGE(PG8_SB(0, 1), cB + hstepB, voffB); PG8_STAGE(PG8_SA(0, 0), cA, voffA); PG8_STAGE(PG8_SA(0, 1), cA + hstepA, voffA);
        if (wr == 1) PG8_BAR;
        PG8_WAIT_V(2); PG8_BAR;
        PG8_STAGE(PG8_SB(1, 0), cB + kstep, voffB); PG8_STAGE(PG8_SA(1, 0), cA + kstep, voffA); PG8_STAGE(PG8_SB(1, 1), cB + hstepB + kstep, voffB);
        PG8_WAIT_V(6); PG8_BAR;
    } else {
        PG8_STAGE(PG8_SB(0, 0), cB, voffB); PG8_STAGE(PG8_SA(0, 0), cA, voffA); PG8_STAGE(PG8_SB(0, 1), cB + hstepB, voffB); PG8_STAGE(PG8_SA(0, 1), cA + hstepA, voffA);
        if (wr == 1) PG8_BAR;
        PG8_WAIT_V(4); PG8_BAR;
        PG8_STAGE(PG8_SB(1, 0), cB + kstep, voffB); PG8_STAGE(PG8_SA(1, 0), cA + kstep, voffA); PG8_STAGE(PG8_SB(1, 1), cB + hstepB + kstep, voffB);
        PG8_WAIT_V(6); PG8_BAR;
    }
    for (;;) {
        const bool has_next = S.next(ui + 1, nxt);
        const char* nA = has_next ? (const char*)g.A + (size_t)nxt.pm * tstepA : cA; const char* nB = has_next ? (const char*)g.Bt + (size_t)nxt.pb * tstepB : cB;
        for (int t = 0; t < nt; t += 2) {
            const bool last = (t == nt - 2);
            const char* a1 = cA + (size_t)(t + 1) * kstep;
            const char* a2 = last ? nA : cA + (size_t)(t + 2) * kstep; const char* b2 = last ? nB : cB + (size_t)(t + 2) * kstep;
            const char* a3 = a2 + kstep; const char* b3 = b2 + kstep;
            if (last && has_next) S.a_ready(nxt);
            if constexpr (SP2) {
            PG8_LDB(B0, 0, 0); PG8_LDB(B1, 0, 1); PG8_SCHED; PG8_LDA(At, 0, 0); PG8_STAGE(PG8_SA(1, 1), a1 + hstepA, voffA);
            PG8_WAIT_V(8); PG8_WAIT_L(0); PG8_BAR; PG8_MMA(0, 0, At, B0); PG8_MMA(0, 1, At, B1); PG8_BAR; PG8_SCHED;
            PG8_LDA(At, 0, 1); PG8_STAGE(PG8_SB(0, 0), b2, voffB); PG8_STAGE(PG8_SB(0, 1), b2 + hstepB, voffB); PG8_STAGE(PG8_SA(0, 0), a2, voffA);
            PG8_WAIT_V(8); PG8_WAIT_L(0); PG8_BAR; PG8_MMA(1, 0, At, B0); PG8_MMA(1, 1, At, B1); PG8_BAR; PG8_SCHED;
            PG8_LDB(B0, 1, 0); PG8_LDB(B1, 1, 1); PG8_SCHED; PG8_LDA(At, 1, 0); PG8_STAGE(PG8_SA(0, 1), a2 + hstepA, voffA);
            PG8_WAIT_V(8); PG8_WAIT_L(0); PG8_BAR; PG8_MMA(0, 0, At, B0); PG8_MMA(0, 1, At, B1); PG8_BAR; PG8_SCHED;
            PG8_LDA(At, 1, 1); PG8_STAGE(PG8_SB(1, 0), b3, voffB); PG8_STAGE(PG8_SB(1, 1), b3 + hstepB, voffB); PG8_STAGE(PG8_SA(1, 0), a3, voffA);
            PG8_WAIT_V(8); PG8_WAIT_L(0); PG8_BAR; PG8_MMA(1, 0, At, B0); PG8_MMA(1, 1, At, B1); PG8_BAR; PG8_SCHED;
            } else {
            PG8_LDB(B0, 0, 0); PG8_SCHED; PG8_LDA(At, 0, 0); PG8_STAGE(PG8_SA(1, 1), a1 + hstepA, voffA);
            PG8_WAIT_L(8); PG8_BAR; PG8_WAIT_L(0); PG8_MMA(0, 0, At, B0); PG8_BAR; PG8_SCHED;
            PG8_LDB(B1, 0, 1); PG8_STAGE(PG8_SB(0, 0), b2, voffB);
            PG8_BAR; PG8_WAIT_L(0); PG8_MMA(0, 1, At, B1); PG8_BAR;
            PG8_LDA(At, 0, 1); PG8_STAGE(PG8_SA(0, 0), a2, voffA);
            PG8_BAR; PG8_WAIT_L(0); PG8_MMA(1, 0, At, B0); PG8_BAR; PG8_SCHED;
            PG8_STAGE(PG8_SB(0, 1), b2 + hstepB, voffB);
            PG8_WAIT_V(6); PG8_BAR; PG8_MMA(1, 1, At, B1); PG8_BAR;
            PG8_LDB(B0, 1, 0); PG8_SCHED; PG8_LDA(At, 1, 0); PG8_STAGE(PG8_SA(0, 1), a2 + hstepA, voffA);
            PG8_WAIT_L(8); PG8_BAR; PG8_WAIT_L(0); PG8_MMA(0, 0, At, B0); PG8_BAR; PG8_SCHED;
            PG8_LDB(B1, 1, 1); PG8_STAGE(PG8_SB(1, 0), b3, voffB);
            PG8_BAR; PG8_WAIT_L(0); PG8_MMA(0, 1, At, B1); PG8_BAR;
            PG8_LDA(At, 1, 1); PG8_STAGE(PG8_SA(1, 0), a3, voffA);
            PG8_BAR; PG8_WAIT_L(0); PG8_MMA(1, 0, At, B0); PG8_BAR; PG8_SCHED;
            PG8_STAGE(PG8_SB(1, 1), b3 + hstepB, voffB);
            PG8_WAIT_V(6); PG8_BAR; PG8_MMA(1, 1, At, B1); PG8_BAR;
            }
        }
        if constexpr (ALIGN_EPI) { if (wr == 0) PG8_BAR; }
        if constexpr (!Epi::AFTER_DRAIN) { E(acc, cur, wr, wc, fr, fq); S.done(cur); }
        if (!has_next) break;
#pragma unroll
        for (int a = 0; a < 2; ++a)
#pragma unroll
            for (int b = 0; b < 2; ++b)
#pragma unroll
                for (int m = 0; m < 4; ++m)
#pragma unroll
                    for (int n = 0; n < 2; ++n) acc[a][b][m][n] = (f32x4){0.f, 0.f, 0.f, 0.f};
        cur = nxt; cA = nA; cB = nB; ++ui;
        if constexpr (ALIGN_EPI) { if (wr == 1) PG8_BAR; }
    }
    PG8_WAIT_V(0);
    if constexpr (!ALIGN_EPI) { if (wr == 0) PG8_BAR; }
    PG8_BAR;
    if constexpr (Epi::AFTER_DRAIN) { E.fused(acc, cur, wr, wc, fr, fq, lds, wid, lane); S.done(cur); }
#undef PG8_SA
#undef PG8_SB
#undef PG8_STAGE
#undef PG8_LDA
#undef PG8_LDB
#undef PG8_MMA
#undef PG8_WAIT_V
#undef PG8_WAIT_L
#undef PG8_BAR
#undef PG8_SCHED
}

}

namespace epi {
using pg8::Unit;
typedef const f32x4 (&AccRef)[2][2][4][2];

__device__ __forceinline__ void store_vt(AccRef acc, bf16_t* vt, int kk0, int wc, int fq) {
#pragma unroll
    for (int bj = 0; bj < 2; ++bj)
#pragma unroll
        for (int n = 0; n < 2; ++n)
#pragma unroll
            for (int j = 0; j < 4; ++j) { bf16_t* cp = vt + (size_t)(128 * bj + 32 * wc + 8 * fq + 4 * n + j) * SK + kk0;
#pragma unroll
                for (int ai = 0; ai < 2; ++ai)
#pragma unroll
                    for (int m = 0; m < 4; ++m) cp[ai * 128 + m * 16] = (bf16_t)(pk2(acc[ai][bj][m][n][j], 0.f) & 0xffffu);
                asm volatile("" ::: "memory"); }
}

struct EpiInProj {
    static constexpr bool PERM = true, AFTER_DRAIN = false;
    bf16_t* P; bf16_t* Vt;
    __device__ __forceinline__ void operator()(AccRef acc, const Unit& u, int wr, int wc, int fr, int fq) const {
        asm volatile("" : "+v"(fr), "+v"(fq));
        if (u.pn >= 13 && u.pn <= 15) {
            const int b = u.pm / 17, kk0 = (u.pm % 17) * 256 + wr * 64 + fr;
            store_vt(acc, Vt + ((size_t)b * VT_ROWS + (u.pn - 13) * 256) * SK, kk0, wc, fq);
        } else {
            const int pcol = (u.pn < 13 ? u.pn : 13) * 256 + wc * 32 + 8 * fq;
#pragma unroll
            for (int ai = 0; ai < 2; ++ai)
#pragma unroll
                for (int m = 0; m < 4; ++m) { bf16_t* rowp = P + (size_t)(u.pm * 256 + ai * 128 + wr * 64 + m * 16 + fr) * PW + pcol;
#pragma unroll
                    for (int bj = 0; bj < 2; ++bj) { const f32x4 v0 = acc[ai][bj][m][0], v1 = acc[ai][bj][m][1];
                        u32x4 w; w.x = pk2(v0[0], v0[1]); w.y = pk2(v0[2], v0[3]); w.z = pk2(v1[0], v1[1]); w.w = pk2(v1[2], v1[3]);
                        *(u32x4*)(rowp + bj * 128) = w; } }
        }
    }
};

struct EpiQup {
    static constexpr bool PERM = false, AFTER_DRAIN = false;
    bf16_t* QC; const float* tab; float scale;
    __device__ __forceinline__ void operator()(AccRef acc, const Unit& u, int wr, int wc, int fr, int fq) const {
        asm volatile("" : "+v"(fr), "+v"(fq));
        const bool is_lat = (u.pm % 17) != 0;
        const int kkb = (u.pm % 17) * 256 - 256 + wr * 64 + fr;
#pragma unroll
        for (int bj = 0; bj < 2; ++bj) {
            const int cb = 8 * u.pn + 4 * bj + wc; const bool rope = (cb % 3) == 2;
#pragma unroll
            for (int ai = 0; ai < 2; ++ai)
#pragma unroll
                for (int m = 0; m < 4; ++m) {
                    const int t = kkb + ai * 128 + m * 16;
                    bf16_t* rowp = QC + (size_t)(u.pm * 256 + ai * 128 + wr * 64 + m * 16 + fr) * 768 + u.pn * 256 + bj * 128 + wc * 32 + 4 * fq;
#pragma unroll
                    for (int n = 0; n < 2; ++n) {
                        f32x4 v = acc[ai][bj][m][n];
                        if (rope) {
                            const int ln = fq * 16 + fr; f32x4 p; p[0] = shfl_xor_l(v[0], 32, ln); p[1] = shfl_xor_l(v[1], 32, ln); p[2] = shfl_xor_l(v[2], 32, ln); p[3] = shfl_xor_l(v[3], 32, ln);
                            if (is_lat) {
                                const int pos = n ? (t & 63) : (t >> 6);
                                const f32x4 cs = *(const f32x4*)(tab + pos * 8 + 4 * (fq & 1)), sn = *(const f32x4*)(tab + 512 + pos * 8 + 4 * (fq & 1));
                                v = (fq < 2) ? (v * cs - p * sn) : (v * cs + p * sn);
                            }
                        }
                        v = v * scale;
                        u32x2 w; w.x = pk2(v[0], v[1]); w.y = pk2(v[2], v[3]);
                        *(u32x2*)(rowp + n * 16) = w;
                    }
                }
        }
    }
};

struct EpiKVup {
    static constexpr bool PERM = true, AFTER_DRAIN = false;
    bf16_t* KC; bf16_t* Vt;
    __device__ __forceinline__ void operator()(AccRef acc, const Unit& u, int wr, int wc, int fr, int fq) const {
        asm volatile("" : "+v"(fr), "+v"(fq));
        if (u.pn >= 2) {
            const int b = u.pm / 17, kk0 = (u.pm % 17) * 256 + wr * 64 + fr;
            store_vt(acc, Vt + ((size_t)b * VT_ROWS + 768 + (u.pn - 2) * 256) * SK, kk0, wc, fq);
        } else {
#pragma unroll
            for (int ai = 0; ai < 2; ++ai)
#pragma unroll
                for (int m = 0; m < 4; ++m) { bf16_t* rowp = KC + (size_t)(u.pm * 256 + ai * 128 + wr * 64 + m * 16 + fr) * 768;
#pragma unroll
                    for (int bj = 0; bj < 2; ++bj) { const int c = u.pn * 256 + bj * 128 + wc * 32 + 8 * fq; const f32x4 v0 = acc[ai][bj][m][0], v1 = acc[ai][bj][m][1];
                        u32x4 w; w.x = pk2(v0[0], v0[1]); w.y = pk2(v0[2], v0[3]); w.z = pk2(v1[0], v1[1]); w.w = pk2(v1[2], v1[3]);
                        *(u32x4*)(rowp + (c >> 6) * 96 + (c & 63)) = w; } }
        }
    }
};

struct EpiResidOrY {
    static constexpr bool PERM = false, AFTER_DRAIN = false;
    float* H; const float* gate; bf16_t* Y; int mode;
    __device__ __forceinline__ void operator()(AccRef acc, const Unit& u, int wr, int wc, int fr, int fq) const {
        asm volatile("" : "+v"(fr), "+v"(fq));
        const int col0 = u.pn * 256 + wc * 32 + 4 * fq;
        if (mode == 0) {
            const int modv = (u.pm % 17 == 0) ? 4 : u.pm / 17;
            const float* gv = gate + (size_t)modv * 12288 + col0;
            f32x4 g4[2][2];
#pragma unroll
            for (int bj = 0; bj < 2; ++bj)
#pragma unroll
                for (int n = 0; n < 2; ++n) g4[bj][n] = *(const f32x4*)(gv + bj * 128 + n * 16);
#pragma unroll
            for (int ai = 0; ai < 2; ++ai)
#pragma unroll
                for (int m = 0; m < 4; ++m) { float* hp = H + (size_t)(u.pm * 256 + ai * 128 + wr * 64 + m * 16 + fr) * DM + col0;
#pragma unroll
                    for (int bj = 0; bj < 2; ++bj)
#pragma unroll
                        for (int n = 0; n < 2; ++n) { f32x4 hv = *(const f32x4*)(hp + bj * 128 + n * 16); hv = hv + g4[bj][n] * acc[ai][bj][m][n]; *(f32x4*)(hp + bj * 128 + n * 16) = hv; }
                    if (m & 1) asm volatile("" ::: "memory"); }
        } else {
#pragma unroll
            for (int ai = 0; ai < 2; ++ai)
#pragma unroll
                for (int m = 0; m < 4; ++m) { bf16_t* yp = Y + (size_t)(u.pm * 256 + ai * 128 + wr * 64 + m * 16 + fr) * DM + col0;
#pragma unroll
                    for (int bj = 0; bj < 2; ++bj)
#pragma unroll
                        for (int n = 0; n < 2; ++n) { const f32x4 v = acc[ai][bj][m][n]; u32x2 w; w.x = pk2(v[0], v[1]); w.y = pk2(v[2], v[3]); *(u32x2*)(yp + bj * 128 + n * 16) = w; } }
        }
    }
};

struct EpiGU {
    static constexpr bool PERM = true, AFTER_DRAIN = false;
    bf16_t* ACT;
    __device__ __forceinline__ void operator()(AccRef acc, const Unit& u, int wr, int wc, int fr, int fq) const {
        asm volatile("" : "+v"(fr), "+v"(fq));
        const int col0 = u.pn * 128 + wc * 32 + 8 * fq;
#pragma unroll
        for (int ai = 0; ai < 2; ++ai)
#pragma unroll
            for (int m = 0; m < 4; ++m) {
                const f32x4 g0 = acc[ai][0][m][0], g1 = acc[ai][0][m][1], u0 = acc[ai][1][m][0], u1 = acc[ai][1][m][1];
                u32x4 w;
                w.x = pk2(silu_f(g0[0]) * u0[0], silu_f(g0[1]) * u0[1]); w.y = pk2(silu_f(g0[2]) * u0[2], silu_f(g0[3]) * u0[3]);
                w.z = pk2(silu_f(g1[0]) * u1[0], silu_f(g1[1]) * u1[1]); w.w = pk2(silu_f(g1[2]) * u1[2], silu_f(g1[3]) * u1[3]);
                *(u32x4*)(ACT + (size_t)(u.pm * 256 + ai * 128 + wr * 64 + m * 16 + fr) * FF + col0) = w;
            }
    }
};
}

namespace att {
constexpr int VPITCH = 72;
constexpr int KBUF_B = 64 * 104 * 2;
constexpr int VBUF_B = 128 * VPITCH * 2;
constexpr int LDS_K = 0, LDS_V = 2 * KBUF_B, LDS_END = LDS_V + 2 * VBUF_B;
static_assert(LDS_END <= RING_BYTES, "attention LDS");
constexpr float NEG = -1.0e30f;

__device__ __forceinline__ bf16x8 pack8(const f32x16& s, int b) {
    u32x4 w; w.x = pk2(s[b], s[b + 1]); w.y = pk2(s[b + 2], s[b + 3]); w.z = pk2(s[b + 4], s[b + 5]); w.w = pk2(s[b + 6], s[b + 7]);
    return __builtin_bit_cast(bf16x8, w);
}

template <int DK, int DV>
__device__ __forceinline__ void attn_pass(LAS unsigned char* lds, const bf16_t* qptr, const bf16_t* kbase, int kpitch, const bf16_t* vtbase, int nt, int tlo, bool wnd, int qpos,
                                          f32x16 (&o)[DV / 32], float& m_out, float& l_out) {
    constexpr int KROW = DK + 8, KCH = DK / 8, NKP = 64 * KCH, KPT = (NKP + 511) / 512, NVP = DV * 8, VPT = NVP / 512, NKS = DK / 16, NDB = DV / 32;
    const int tid = opaque_tid(), lane = tid & 63, i32 = lane & 31, hi = lane >> 5;
    int kgo[KPT], klo[KPT]; bool kact[KPT];
#pragma unroll
    for (int p = 0; p < KPT; ++p) { const int idx = tid + 512 * p; kact[p] = idx < NKP; const int row = idx / KCH, ch = idx % KCH; kgo[p] = row * kpitch + ch * 8; klo[p] = (row * KROW + ch * 8) * 2; }
    int vgo[VPT], vlo[VPT];
#pragma unroll
    for (int p = 0; p < VPT; ++p) { const int idx = tid + 512 * p; const int row = idx >> 3, ch = idx & 7; vgo[p] = row * SK + ch * 8; vlo[p] = (row * VPITCH + ch * 8) * 2; }
    bf16x8 q[NKS];
#pragma unroll
    for (int ks = 0; ks < NKS; ++ks) q[ks] = *(const bf16x8*)(qptr + 16 * ks);
    const int kap = (i32 & 0x13) | ((i32 & 4) << 1) | ((i32 & 8) >> 1);
    const int kfo = (kap * KROW + 8 * hi) * 2, vfo = (i32 * VPITCH + 8 * hi) * 2;
#pragma unroll
    for (int db = 0; db < NDB; ++db)
#pragma unroll
        for (int r = 0; r < 16; ++r) o[db][r] = 0.f;
    float m = NEG, l = 0.f;
    u32x4 kr[KPT], vr[VPT];
#define ATT_GLOAD(t_) do { const bf16_t* kg_ = kbase + (size_t)(64 * (t_)) * kpitch; const bf16_t* vg_ = vtbase + 64 * (t_); \
        _Pragma("unroll") for (int p = 0; p < KPT; ++p) if (kact[p]) kr[p] = *(const u32x4*)(kg_ + kgo[p]); \
        _Pragma("unroll") for (int p = 0; p < VPT; ++p) vr[p] = *(const u32x4*)(vg_ + vgo[p]); } while (0)
#define ATT_LSTORE(buf_) do { \
        _Pragma("unroll") for (int p = 0; p < KPT; ++p) if (kact[p]) *(LAS u32x4*)(lds + LDS_K + (buf_) * KBUF_B + klo[p]) = kr[p]; \
        _Pragma("unroll") for (int p = 0; p < VPT; ++p) *(LAS u32x4*)(lds + LDS_V + (buf_) * VBUF_B + vlo[p]) = vr[p]; } while (0)
    ATT_GLOAD(0); ATT_LSTORE(0);
    __syncthreads();
    for (int jj = 0; jj < nt; ++jj) {
        const int cur = jj & 1; const bool more = (jj + 1) < nt;
        const int t = jj < 4 ? jj : tlo + jj - 4;
        if (more) { const int tn = (jj + 1) < 4 ? (jj + 1) : tlo + jj - 3; ATT_GLOAD(tn); }
        const LAS unsigned char* kb = lds + LDS_K + cur * KBUF_B + kfo;
        const LAS unsigned char* vb = lds + LDS_V + cur * VBUF_B + vfo;
        f32x16 s0, s1;
#pragma unroll
        for (int r = 0; r < 16; ++r) { s0[r] = 0.f; s1[r] = 0.f; }
#pragma unroll
        for (int ks = 0; ks < NKS; ++ks) {
            const bf16x8 k0 = *(const LAS bf16x8*)(kb + ks * 32), k1 = *(const LAS bf16x8*)(kb + 32 * KROW * 2 + ks * 32);
            s0 = __builtin_amdgcn_mfma_f32_32x32x16_bf16(k0, q[ks], s0, 0, 0, 0);
            s1 = __builtin_amdgcn_mfma_f32_32x32x16_bf16(k1, q[ks], s1, 0, 0, 0);
        }
        if (wnd && t >= 4) {
            const int d0 = qpos - (64 * t - 256 + 8 * hi);
#pragma unroll
            for (int r = 0; r < 16; ++r) { const int kidx = (r & 7) + 16 * (r >> 3); const int da = d0 - kidx, db_ = d0 - 32 - kidx;
                if (da > 128 || da < -128) s0[r] = NEG; if (db_ > 128 || db_ < -128) s1[r] = NEG; }
        }
        float mx = fmaxf(s0[0], s1[0]);
#pragma unroll
        for (int r = 1; r < 16; ++r) mx = fmaxf(mx, fmaxf(s0[r], s1[r]));
        mx = xmax32(mx);
        const float mn = fmaxf(m, mx);
        const float alpha = __builtin_amdgcn_exp2f(m - mn);
        m = mn;
        float ps = 0.f;
#pragma unroll
        for (int r = 0; r < 16; ++r) { s0[r] = __builtin_amdgcn_exp2f(s0[r] - mn); s1[r] = __builtin_amdgcn_exp2f(s1[r] - mn); ps += s0[r] + s1[r]; }
        l = l * alpha + ps;
#pragma unroll
        for (int db = 0; db < NDB; ++db)
#pragma unroll
            for (int r = 0; r < 16; ++r) o[db][r] *= alpha;
        bf16x8 pf[4];
        pf[0] = pack8(s0, 0); pf[1] = pack8(s0, 8); pf[2] = pack8(s1, 0); pf[3] = pack8(s1, 8);
#pragma unroll
        for (int db = 0; db < NDB; ++db)
#pragma unroll
            for (int c = 0; c < 4; ++c) {
                const bf16x8 vf = *(const LAS bf16x8*)(vb + db * (32 * VPITCH * 2) + c * 32);
                o[db] = __builtin_amdgcn_mfma_f32_32x32x16_bf16(vf, pf[c], o[db], 0, 0, 0);
            }
        if (more) ATT_LSTORE(cur ^ 1);
        __syncthreads();
    }
#undef ATT_GLOAD
#undef ATT_LSTORE
    m_out = m; l_out = l;
}

template <int NDB>
__device__ __forceinline__ void store_o(const f32x16 (&o)[NDB], float inv, bf16_t* orow, int hi) {
#pragma unroll
    for (int db = 0; db < NDB; ++db)
#pragma unroll
        for (int rg = 0; rg < 4; ++rg) { u32x2 w; w.x = pk2(o[db][4 * rg] * inv, o[db][4 * rg + 1] * inv); w.y = pk2(o[db][4 * rg + 2] * inv, o[db][4 * rg + 3] * inv);
            *(u32x2*)(orow + 32 * db + 8 * rg + 4 * hi) = w; }
}

struct Tensors { const bf16_t* P; const bf16_t* QC; const bf16_t* KC; const bf16_t* Vt; bf16_t* O; const float* subln; const float* sink; float lam, one_m_lam_init; };

__device__ __forceinline__ void attn_phase(LAS unsigned char* lds, const Tensors& T, int vcu, int G, int bx, bool with_ctx) {
#ifndef ATT_MASK
#define ATT_MASK 7
#endif
    if (ATT_MASK & 1) {
        const int tid = opaque_tid(), lane = tid & 63, i32 = lane & 31, hi = lane >> 5, wid = tid >> 6;
        const int nper = (256 + G - 1) / G;
        const int nctx = with_ctx ? ((bx < 16) ? (16 - bx + G - 1) / G : 0) : 0;
        for (int it = 0; it < nper + nctx; ++it) {
            int b, h, qrow0, nt;
            if (it < nper) { const int u = vcu * nper + it; if (u >= 256) continue; const int combo = u >> 4, qb = u & 15; b = combo >> 2; h = combo & 3; qrow0 = b * SK + 256 + 256 * qb; nt = 68; }
            else { const int u = bx + (it - nper) * G; b = u >> 2; h = u & 3; qrow0 = b * SK; nt = 4; }
            const int qrow = qrow0 + wid * 32 + i32;
            unsigned keep[4][8];
#pragma unroll 1
            for (int mp = 1; mp >= 0; --mp) {
                f32x16 o[4]; float m, l;
                attn_pass<64, 128>(lds, T.P + (size_t)qrow * PW + mp * 256 + h * 64 + 8 * hi, T.P + (size_t)(b * SK) * PW + 2304 + mp * 256 + h * 64, PW,
                                   T.Vt + ((size_t)b * VT_ROWS + h * 128) * SK, nt, 4, false, 0, o, m, l);
                l = xsum32(l);
                const float inv = 1.0f / l;
                if (mp == 1) {
#pragma unroll
                    for (int db = 0; db < 4; ++db)
#pragma unroll
                        for (int i = 0; i < 8; ++i) keep[db][i] = pk2(o[db][2 * i] * inv, o[db][2 * i + 1] * inv);
                } else {
                    float ss = 0.f;
#pragma unroll
                    for (int db = 0; db < 4; ++db)
#pragma unroll
                        for (int r = 0; r < 16; ++r) { const float k2 = (r & 1) ? bfhi(keep[db][r >> 1]) : bflo(keep[db][r >> 1]); const float d = o[db][r] * inv - T.lam * k2; o[db][r] = d; ss += d * d; }
                    ss = xsum32(ss);
                    const float rs = __builtin_amdgcn_rsqf(ss * (1.0f / 128.0f) + EPS) * T.one_m_lam_init;
                    bf16_t* orow = T.O + (size_t)qrow * DM + h * 128;
#pragma unroll
                    for (int db = 0; db < 4; ++db)
#pragma unroll
                        for (int rg = 0; rg < 4; ++rg) { const int d0 = 32 * db + 8 * rg + 4 * hi; const f32x4 g = *(const f32x4*)(T.subln + d0);
                            u32x2 w; w.x = pk2(o[db][4 * rg] * rs * g[0], o[db][4 * rg + 1] * rs * g[1]); w.y = pk2(o[db][4 * rg + 2] * rs * g[2], o[db][4 * rg + 3] * rs * g[3]);
                            *(u32x2*)(orow + d0) = w; }
                }
            }
        }
    }
    if (ATT_MASK & 2) {
        const int tid = opaque_tid(), lane = tid & 63, i32 = lane & 31, hi = lane >> 5, wid = tid >> 6;
        const int nper = (512 + G - 1) / G;
        const int c0 = (bx + G - (16 % G)) % G;
        const int nctx = with_ctx ? ((c0 < 64) ? (64 - c0 + G - 1) / G : 0) : 0;
        for (int it = 0; it < 2 * nper + nctx; ++it) {
            int kind, b, head, qrow0, nt, tlo, qpos0; bool wnd;
            if (it < 2 * nper) { kind = it >= nper ? 1 : 0; const int u = vcu * nper + (it - kind * nper); if (u >= 512) continue; const int combo = u >> 6, hq = (u >> 4) & 3, qb = u & 15;
                b = combo >> 1; head = (combo & 1) * 4 + hq; qrow0 = b * SK + 256 + 256 * qb; qpos0 = 256 * qb;
                if (kind) { wnd = true; const int lo = qpos0 - 128 < 0 ? 0 : qpos0 - 128, hi_ = qpos0 + 384 > SEQ ? SEQ : qpos0 + 384; tlo = 4 + lo / 64; nt = 4 + (hi_ - lo) / 64; } else { wnd = false; tlo = 4; nt = 68; } }
            else { const int u = c0 + (it - 2 * nper) * G; kind = u >> 5; b = (u & 31) >> 3; head = u & 7; qrow0 = b * SK; nt = 4; tlo = 4; wnd = false; qpos0 = 0; }
            const int g = head >> 2;
            const int qcol = (kind ? 1792 : 512) + head * 64, kcol = (kind ? 2944 : 2816) + g * 64, vrow = (kind ? 640 : 512) + g * 64, ocol = (kind ? 1536 : 512) + head * 64;
            const int qrow = qrow0 + wid * 32 + i32;
            f32x16 o[2]; float m, l;
            attn_pass<64, 64>(lds, T.P + (size_t)qrow * PW + qcol + 8 * hi, T.P + (size_t)(b * SK) * PW + kcol, PW, T.Vt + ((size_t)b * VT_ROWS + vrow) * SK, nt, tlo, wnd, qpos0 + wid * 32 + i32, o, m, l);
            l = xsum32(l);
            if (kind) l += __builtin_amdgcn_exp2f(T.sink[head] * LOG2E - m);
            store_o<2>(o, 1.0f / l, T.O + (size_t)qrow * DM + ocol, hi);
        }
    }
    if (ATT_MASK & 4) {
        const int tid = opaque_tid(), lane = tid & 63, i32 = lane & 31, hi = lane >> 5, wid = tid >> 6;
        const int nper = (512 + G - 1) / G;
        const int c0 = (bx + G - (80 % G)) % G;
        const int nctx = with_ctx ? ((c0 < 32) ? (32 - c0 + G - 1) / G : 0) : 0;
        for (int it = 0; it < nper + nctx; ++it) {
            int b, h, qrow0, nt;
            if (it < nper) { const int u = vcu * nper + it; if (u >= 512) continue; const int combo = u >> 4, qb = u & 15; b = combo >> 3; h = combo & 7; qrow0 = b * SK + 256 + 256 * qb; nt = 68; }
            else { const int u = c0 + (it - nper) * G; b = u >> 3; h = u & 7; qrow0 = b * SK; nt = 4; }
            const int qrow = qrow0 + wid * 32 + i32;
            f32x16 o[2]; float m, l;
            attn_pass<96, 64>(lds, T.QC + (size_t)qrow * 768 + h * 96 + 8 * hi, T.KC + (size_t)(b * SK) * 768 + h * 96, 768, T.Vt + ((size_t)b * VT_ROWS + 768 + h * 64) * SK, nt, 4, false, 0, o, m, l);
            l = xsum32(l);
            store_o<2>(o, 1.0f / l, T.O + (size_t)qrow * DM + 1024 + h * 64, hi);
        }
    }
}
}

#define XB_TMO      128
#define XB_XCNT(j)  (256  + 64 * (j))
#define XB_XSUB(j)  (1280 + 64 * (j))
#define XB_XGEN(j)  (2304 + 64 * (j))
#define XB_TOP      3328
#define XB_TOPGEN   3392
#define XCD_BAR_WORDS 3456
#define XB_SPIN_CAP (1u << 18)

__device__ __forceinline__ unsigned xb_ld(unsigned* p)              { return __hip_atomic_load(p, __ATOMIC_RELAXED, __HIP_MEMORY_SCOPE_AGENT); }
__device__ __forceinline__ unsigned xb_add(unsigned* p, unsigned v) { return __hip_atomic_fetch_add(p, v, __ATOMIC_RELAXED, __HIP_MEMORY_SCOPE_AGENT); }
__device__ __forceinline__ unsigned xb_xcc_id() { return (unsigned)__builtin_amdgcn_s_getreg((3 << 11) | 20) & 0xFu; }
#define XB_SPIN(cond, bar) do { unsigned _sp = 0; while (cond) { __builtin_amdgcn_s_sleep(1); \
    if ((++_sp & 255u) == 0u) { if (xb_ld(&(bar)[XB_TMO])) break; if (_sp > XB_SPIN_CAP) { atomicAdd(&(bar)[XB_TMO], 1u); break; } } } } while (0)

struct XcdBarrier {
    unsigned* bar; unsigned x;
    volatile LAS unsigned* st;
};

__device__ __forceinline__ XcdBarrier xcd_barrier_post(unsigned* bar, volatile LAS unsigned* st) {
    XcdBarrier b; b.bar = bar; b.x = xb_xcc_id(); b.st = st;
    if (threadIdx.x == 0) (void)xb_add(&bar[XB_XCNT(b.x)], 1u);
    return b;
}
__device__ __forceinline__ void xcd_barrier_complete(unsigned* bar, unsigned x, unsigned& nloc, unsigned& nx) {
    const unsigned G = gridDim.x * gridDim.y * gridDim.z;
    unsigned sum, cnt, mine, sp = 0u;
    for (;;) {
        sum = 0u; cnt = 0u; mine = 0u;
#pragma unroll
        for (unsigned j = 0; j < 16; ++j) { const unsigned c = xb_ld(&bar[XB_XCNT(j)]); sum += c; cnt += (c > 0u) ? 1u : 0u; mine = (j == x) ? c : mine; }
        if (sum == G) break;
        __builtin_amdgcn_s_sleep(1);
        if ((++sp & 255u) == 0u) { if (xb_ld(&bar[XB_TMO])) break; if (sp > XB_SPIN_CAP) { atomicAdd(&bar[XB_TMO], 1u); break; } }
    }
    nloc = mine > 0u ? mine : 1u; nx = cnt > 0u ? cnt : 1u;
}

__device__ __forceinline__ void xcd_barrier(const XcdBarrier& b) {
    asm volatile("s_waitcnt vmcnt(0)" ::: "memory");
    __syncthreads();
    if (threadIdx.x == 0) {
        unsigned* bar = b.bar;
        __builtin_amdgcn_s_waitcnt(0);
        unsigned nloc = b.st[0], nx = b.st[1];
        if (nloc == 0u) { xcd_barrier_complete(bar, b.x, nloc, nx); b.st[0] = nloc; b.st[1] = nx; }
        const unsigned old = xb_add(&bar[XB_XSUB(b.x)], 1u);
        const unsigned gen = old / nloc;
        if (old + 1u == (gen + 1u) * nloc) {
            __builtin_amdgcn_fence(__ATOMIC_RELEASE, "agent");
            asm volatile("s_waitcnt vmcnt(0)" ::: "memory");
            const unsigned og = xb_add(&bar[XB_TOP], 1u);
            const unsigned tg = og / nx;
            if (og + 1u == (tg + 1u) * nx) xb_add(&bar[XB_TOPGEN], 1u);
            else XB_SPIN(xb_ld(&bar[XB_TOPGEN]) == tg, bar);
            __builtin_amdgcn_fence(__ATOMIC_ACQUIRE, "agent");
            xb_add(&bar[XB_XGEN(b.x)], 1u);
            asm volatile("s_waitcnt vmcnt(0)" ::: "memory");
        } else {
            XB_SPIN(xb_ld(&bar[XB_XGEN(b.x)]) == gen, bar);
            __builtin_amdgcn_fence(__ATOMIC_ACQUIRE, "agent");
            asm volatile("s_waitcnt vmcnt(0)" ::: "memory");
        }
    }
    __syncthreads();
}


__device__ __forceinline__ void p0_transpose_item(const float* W, int K, int N, bf16_t* WT, int k0, int n0, int drow0, LAS float* scr, int lane) {
#pragma unroll 8
    for (int i = 0; i < 32; ++i) { const int kk = 2 * i + (lane >> 5); scr[kk * 33 + (lane & 31)] = W[(size_t)(k0 + kk) * N + n0 + (lane & 31)]; }
    LDS_WAIT(); asm volatile("" ::: "memory");
    const int c = lane & 7;
#pragma unroll
    for (int j = 0; j < 4; ++j) { const int n = (lane >> 3) + 8 * j; const LAS float* s = scr + (8 * c) * 33 + n;
        u32x4 o; o.x = pk2(s[0 * 33], s[1 * 33]); o.y = pk2(s[2 * 33], s[3 * 33]); o.z = pk2(s[4 * 33], s[5 * 33]); o.w = pk2(s[6 * 33], s[7 * 33]);
        *(GAS u32x4*)(WT + (size_t)(drow0 + n) * K + k0 + 8 * c) = o; }
    LDS_WAIT(); asm volatile("" ::: "memory");
}
__device__ __forceinline__ int map_in(int n0) {
    if (n0 < 2816) return n0;
    if (n0 < 3328) return n0 + 512;
    if (n0 < 3456) return n0 - 512;
    if (n0 < 3584) return n0 + 384;
    if (n0 < 3840) return n0 - 512;
    if (n0 < 3872) return n0 + 256;
    if (n0 < 4000) return n0 - 928;
    return n0 - 32;
}
__device__ __forceinline__ int map_kv(int n0) { const int h = n0 >> 7, j = n0 & 127; return j < 64 ? h * 64 + j : 512 + h * 64 + (j - 64); }
__device__ __forceinline__ int map_gate(int n0) { return (n0 >> 7) * 256 + (n0 & 127); }

__device__ __forceinline__ void dsincos(double x, double& s, double& c) {
    const double TWO_PI = 6.283185307179586476925286766559;
    const double k = __builtin_floor(x / TWO_PI + 0.5);
    const double y = x - k * TWO_PI, y2 = y * y;
    double ts = y, tc = 1.0; s = y; c = 1.0;
    for (int n = 1; n <= 16; ++n) { tc = -tc * y2 / (double)((2 * n - 1) * (2 * n)); ts = -ts * y2 / (double)((2 * n) * (2 * n + 1)); c += tc; s += ts; }
}
struct Args { const float* in[31]; float* out; unsigned char* ws; int ph_lo, ph_hi; };
static_assert(sizeof(Args) == 31 * 8 + 8 + 8 + 8, "Args has no padding");
typedef Args Ptrs;

__device__ __forceinline__ void p0_prologue(const Ptrs& A, LAS unsigned char* lds, int vcu, int G) {
    const int tid = opaque_tid(), lane = tid & 63, wave = tid >> 6;
    float* cst = (float*)(A.ws + WS_CONST);
    {
        LAS float* sl = (LAS float*)lds;
        LAS float* red = (LAS float*)(lds + 5 * 2048 * 4);
        for (int i = tid; i < 5 * 2048; i += 512) { const int v = i >> 11, k = i & 2047; const float x = v < 4 ? A.in[1][v * 2048 + k] : A.in[3][k]; sl[i] = x / (1.0f + __expf(-x)); }
        __syncthreads();
        for (int item = vcu; item < 2 * 192; item += G) {
            const int l = item / 192, n0 = (item % 192) * 64;
            const float* W = A.in[4] + (size_t)l * 2048 * 12288 + n0 + lane;
            float a0 = 0.f, a1 = 0.f, a2 = 0.f, a3 = 0.f, a4 = 0.f;
#pragma unroll 8
            for (int kk = 0; kk < 256; ++kk) { const int k = wave * 256 + kk; const float w = W[(size_t)k * 12288];
                a0 += sl[k] * w; a1 += sl[2048 + k] * w; a2 += sl[4096 + k] * w; a3 += sl[6144 + k] * w; a4 += sl[8192 + k] * w; }
            red[(wave * 5 + 0) * 64 + lane] = a0; red[(wave * 5 + 1) * 64 + lane] = a1; red[(wave * 5 + 2) * 64 + lane] = a2; red[(wave * 5 + 3) * 64 + lane] = a3; red[(wave * 5 + 4) * 64 + lane] = a4;
            __syncthreads();
            if (tid < 320) { const int v = tid >> 6, n = tid & 63; float s = A.in[5][l * 12288 + n0 + n];
#pragma unroll
                for (int w = 0; w < 8; ++w) s += red[(w * 5 + v) * 64 + n];
                cst[CO_MOD + (l * 5 + v) * 12288 + n0 + n] = s; }
            __syncthreads();
        }
    }
    if (blockIdx.x == 0) {
        if (tid < 24) {
            const bool mla = tid >= 16; const int f = mla ? tid - 16 : tid;
            const double r = mla ? 0.31622776601683794 : 0.5623413251903491;
            double inv = 1.0; for (int i = 0; i < f; ++i) inv *= r;
            const float invf = (float)inv;
            for (int pos = 0; pos < 64; ++pos) { double s, c; dsincos((double)((float)pos * invf), s, c);
                if (mla) { cst[CO_ROPEM + pos * 8 + f] = (float)c; cst[CO_ROPEM + 512 + pos * 8 + f] = (float)s; }
                else { cst[CO_ROPEH + pos * 16 + f] = (float)c; cst[CO_ROPEH + 1024 + pos * 16 + f] = (float)s; } }
        }
        if (tid >= 64 && tid < 66) { const int l = tid - 64; float s1 = 0.f, s2 = 0.f;
            for (int i = 0; i < 64; ++i) { s1 += A.in[11][l * 64 + i] * A.in[12][l * 64 + i]; s2 += A.in[13][l * 64 + i] * A.in[14][l * 64 + i]; }
            const float lam_init = l == 0 ? 0.2f : 0.35550906759096926f;
            cst[CO_LAM + l] = __expf(s1) - __expf(s2) + lam_init; }
    }
    {
        float* H = (float*)(A.ws + WS_H);
        const int gw = vcu * 8 + wave, NGW = G * 8;
        for (int r = gw; r < MR; r += NGW) { const int b = r / SK, kk = r % SK;
            const GAS f32x4* src = (const GAS f32x4*)(kk < CTXL ? A.in[2] + ((size_t)b * CTXL + kk) * DM : A.in[0] + ((size_t)b * SEQ + kk - CTXL) * DM) + lane;
            GAS f32x4* dst = (GAS f32x4*)(H + (size_t)r * DM) + lane;
#pragma unroll
            for (int j = 0; j < 8; ++j) dst[64 * j] = src[64 * j]; }
    }
    {
        LAS float* scr = (LAS float*)lds + wave * (64 * 33);
        static_assert(8 * 64 * 33 * 4 <= RING_BYTES, "transpose scratch");
        const int gw = vcu * 8 + wave, NGW = G * 8;
        bf16_t* Win = (bf16_t*)(A.ws + WS_WIN); bf16_t* Wout = (bf16_t*)(A.ws + WS_WOUT); bf16_t* Wq = (bf16_t*)(A.ws + WS_WQUP); bf16_t* Wkv = (bf16_t*)(A.ws + WS_WKVUP);
        bf16_t* Wgu0 = (bf16_t*)(A.ws + WS_WGU0); bf16_t* Wdn0 = (bf16_t*)(A.ws + WS_WDN0); bf16_t* Wgu1 = (bf16_t*)(A.ws + WS_WGU1); bf16_t* Wdn1 = (bf16_t*)(A.ws + WS_WDN1);
        constexpr int I_IN = 32 * 129, I_OUT = 32 * 64, I_Q = 12 * 24, I_KV = 4 * 32, I_G = 32 * 176, I_D = 88 * 64;
        constexpr int S0 = 2 * I_IN, S1 = S0 + 2 * I_OUT, S2 = S1 + 2 * I_Q, S3 = S2 + 2 * I_KV, S4 = S3 + 9 * 3 * I_G;
        static_assert(I_G == I_D, "items");
        for (int it = gw; it < S4; it += NGW) {
            if (it < S0) { const int l = it / I_IN, r = it % I_IN, kb = r / 129, nb = r % 129; p0_transpose_item(A.in[9] + (size_t)l * 2048 * IN_SRC, 2048, IN_SRC, Win + (size_t)l * INW * 2048, 64 * kb, 32 * nb, map_in(32 * nb), scr, lane); }
            else if (it < S1) { const int q = it - S0, l = q / I_OUT, r = q % I_OUT, kb = r / 64, nb = r % 64; p0_transpose_item(A.in[10] + (size_t)l * 2048 * 2048, 2048, 2048, Wout + (size_t)l * 2048 * 2048, 64 * kb, 32 * nb, 32 * nb, scr, lane); }
            else if (it < S2) { const int q = it - S1, l = q / I_Q, r = q % I_Q, kb = r / 24, nb = r % 24; p0_transpose_item(A.in[20] + (size_t)l * 768 * 768, 768, 768, Wq + (size_t)l * 768 * 768, 64 * kb, 32 * nb, 32 * nb, scr, lane); }
            else if (it < S3) { const int q = it - S2, l = q / I_KV, r = q % I_KV, kb = r / 32, nb = r % 32; p0_transpose_item(A.in[21] + (size_t)l * 256 * 1024, 256, 1024, Wkv + (size_t)l * 1024 * 256, 64 * kb, 32 * nb, map_kv(32 * nb), scr, lane); }
            else { const int q = it - S3, j = q / (3 * I_G), r3 = q % (3 * I_G), which = r3 / I_G, r = r3 % I_G;
                if (which < 2) { const int kb = r / 176, nb = r % 176;
                    const float* src = j == 0 ? (which == 0 ? A.in[23] : A.in[24]) : (which == 0 ? A.in[28] : A.in[29]) + (size_t)(j - 1) * 2048 * FF;
                    bf16_t* dst = j == 0 ? Wgu0 : Wgu1 + (size_t)(j - 1) * 11264 * 2048;
                    p0_transpose_item(src, 2048, FF, dst, 64 * kb, 32 * nb, map_gate(32 * nb) + which * 128, scr, lane); }
                else { const int kb = r / 64, nb = r % 64;
                    const float* src = j == 0 ? A.in[25] : A.in[30] + (size_t)(j - 1) * FF * 2048;
                    bf16_t* dst = j == 0 ? Wdn0 : Wdn1 + (size_t)(j - 1) * 2048 * FF;
                    p0_transpose_item(src, FF, 2048, dst, 64 * kb, 32 * nb, 32 * nb, scr, lane); } }
        }
        for (int i = gw * 64 + lane; i < 2 * 224 * 256; i += NGW * 64) { const int l = i / (224 * 256), r = i % (224 * 256);
            *(GAS u32x4*)(Win + ((size_t)l * INW + 4128) * 2048 + (size_t)r * 8) = (u32x4){0u, 0u, 0u, 0u}; }
    }
}

__device__ __forceinline__ void norm_phase(const Ptrs& A, int l, int which, bool route, int vcu, int G) {
    const int tid = opaque_tid(), lane = tid & 63, wave = tid >> 6;
    const float* H = (const float*)(A.ws + WS_H); bf16_t* U = (bf16_t*)(A.ws + WS_U);
    const float* MOD = (const float*)(A.ws + WS_CONST) + CO_MOD + (size_t)l * 5 * 12288 + which * 3 * 2048;
    const float* gain = (which ? A.in[7] : A.in[6]) + l * 2048;
    unsigned* ctl = (unsigned*)(A.ws + WS_CTL); int* rt = (int*)(A.ws + WS_ROUTE);
    const int gw = vcu * 8 + wave, NGW = G * 8, nrows = route ? NLAT : MR;
    for (int i = gw; i < nrows; i += NGW) {
        const int r = route ? (i / SEQ) * SK + CTXL + (i % SEQ) : i;
        const int b = r / SK, modv = (r % SK) < CTXL ? 4 : b;
        const float* sh = MOD + (size_t)modv * 12288; const float* sc = sh + 2048;
        const GAS f32x4* xr = (const GAS f32x4*)(H + (size_t)r * DM) + lane;
        f32x4 v[8]; float ss = 0.f;
#pragma unroll
        for (int j = 0; j < 8; ++j) { v[j] = xr[64 * j]; ss += (v[j].x * v[j].x + v[j].y * v[j].y) + (v[j].z * v[j].z + v[j].w * v[j].w); }
        const float rstd = 1.0f / sqrtf(wave_sum(ss, lane) * (1.0f / DM) + EPS);
        GAS u32x2* o8 = (GAS u32x2*)(U + (size_t)r * DM) + lane;
#pragma unroll
        for (int j = 0; j < 8; ++j) { const int c = 4 * lane + 256 * j; const f32x4 g4 = *(const f32x4*)(gain + c), s4 = *(const f32x4*)(sc + c), h4 = *(const f32x4*)(sh + c);
            v[j] = (v[j] * rstd * g4) * (1.0f + s4) + h4;
            u32x2 w; w.x = pk2(v[j].x, v[j].y); w.y = pk2(v[j].z, v[j].w); o8[64 * j] = w; }
        if (route) {
            const float* wr = A.in[26];
            float lg[8];
#pragma unroll
            for (int e = 0; e < 8; ++e) lg[e] = 0.f;
#pragma unroll
            for (int j = 0; j < 8; ++j)
#pragma unroll
                for (int ii = 0; ii < 4; ++ii) { const int k = 4 * lane + 256 * j + ii; const f32x4 w0 = *(const f32x4*)(wr + k * 8), w1 = *(const f32x4*)(wr + k * 8 + 4); const float x = v[j][ii];
                    lg[0] += x * w0.x; lg[1] += x * w0.y; lg[2] += x * w0.z; lg[3] += x * w0.w; lg[4] += x * w1.x; lg[5] += x * w1.y; lg[6] += x * w1.z; lg[7] += x * w1.w; }
#pragma unroll
            for (int e = 0; e < 8; ++e) lg[e] = wave_sum(lg[e], lane) + A.in[27][e];
            if (lane == 0) {
                int e0 = 0; float v0 = lg[0];
#pragma unroll
                for (int e = 1; e < 8; ++e) if (lg[e] > v0) { v0 = lg[e]; e0 = e; }
                int e1 = -1; float v1 = -3.0e38f;
#pragma unroll
                for (int e = 0; e < 8; ++e) if (e != e0 && lg[e] > v1) { v1 = lg[e]; e1 = e; }
                const float ex = __expf(v1 - v0), w0 = 1.0f / (1.0f + ex), w1 = ex / (1.0f + ex);
                const int s0 = (int)__hip_atomic_fetch_add(ctl + CW_MOE + 64 * e0, 1u, __ATOMIC_RELAXED, __HIP_MEMORY_SCOPE_AGENT);
                const int s1 = (int)__hip_atomic_fetch_add(ctl + CW_MOE + 64 * e1, 1u, __ATOMIC_RELAXED, __HIP_MEMORY_SCOPE_AGENT);
                rt[RO_E + i] = e0; rt[RO_E + NLAT + i] = e1; rt[RO_SLOT + i] = s0; rt[RO_SLOT + NLAT + i] = s1;
                ((float*)rt)[RO_GATE + i] = w0; ((float*)rt)[RO_GATE + NLAT + i] = w1;
            }
        }
    }
}

__device__ __forceinline__ void post_phase(const Ptrs& A, int l, int vcu, int G) {
    const int tid = opaque_tid(), lane = tid & 63, wave = tid >> 6;
    bf16_t* P = (bf16_t*)(A.ws + WS_P); bf16_t* KC = (bf16_t*)(A.ws + WS_KC);
    const float* cst = (const float*)(A.ws + WS_CONST);
    const float* RH = cst + CO_ROPEH; const float* RM = cst + CO_ROPEM;
    const float* qn = A.in[16] + l * 64; const float* kn = A.in[17] + l * 64; const float* cqn = A.in[18] + l * 768; const float* ckn = A.in[19] + l * 256;
    const int gw = vcu * 8 + wave, NGW = G * 8;
    int hcol; bool donorm = false, isq = false; const float* gptr = qn;
    if (lane < 8) { hcol = lane * 64; isq = true; }
    else if (lane < 16) { hcol = 512 + (lane - 8) * 64; isq = true; donorm = true; }
    else if (lane < 24) { hcol = 1792 + (lane - 16) * 64; isq = true; }
    else if (lane < 32) { hcol = 2304 + (lane - 24) * 64; }
    else if (lane < 34) { hcol = 2816 + (lane - 32) * 64; donorm = true; gptr = kn; }
    else { hcol = 2944 + ((lane - 34) & 1) * 64; }
    for (int r = gw; r < MR; r += NGW) {
        const int kk = r % SK; const bool lat = kk >= CTXL; const int t = lat ? kk - CTXL : 0, rpos = t >> 6, cpos = t & 63;
        bf16_t* Pr = P + (size_t)r * PW;
        if (lane < 36) {
            float x[64];
            { const u32x4* src = (const u32x4*)(Pr + hcol);
#pragma unroll
              for (int c = 0; c < 8; ++c) { const u32x4 w = src[c]; x[8 * c] = bflo(w.x); x[8 * c + 1] = bfhi(w.x); x[8 * c + 2] = bflo(w.y); x[8 * c + 3] = bfhi(w.y); x[8 * c + 4] = bflo(w.z); x[8 * c + 5] = bfhi(w.z); x[8 * c + 6] = bflo(w.w); x[8 * c + 7] = bfhi(w.w); } }
            if (donorm) { float ss = 0.f;
#pragma unroll
                for (int i = 0; i < 64; ++i) ss += x[i] * x[i];
                const float rstd = 1.0f / sqrtf(ss * (1.0f / 64.0f) + EPS);
#pragma unroll
                for (int i = 0; i < 64; ++i) x[i] = x[i] * rstd * gptr[i]; }
            if (lat) {
#pragma unroll
                for (int hf = 0; hf < 2; ++hf) { const int pos = hf ? cpos : rpos;
#pragma unroll
                    for (int i = 0; i < 16; ++i) { const float c = RH[pos * 16 + i], s = RH[1024 + pos * 16 + i]; const float x1 = x[32 * hf + i], x2 = x[32 * hf + 16 + i];
                        x[32 * hf + i] = x1 * c - x2 * s; x[32 * hf + 16 + i] = x2 * c + x1 * s; } }
            }
            const float sc = isq ? QS64 : 1.0f;
            { u32x4* dst = (u32x4*)(Pr + hcol);
#pragma unroll
              for (int c = 0; c < 8; ++c) { u32x4 w; w.x = pk2(x[8 * c] * sc, x[8 * c + 1] * sc); w.y = pk2(x[8 * c + 2] * sc, x[8 * c + 3] * sc); w.z = pk2(x[8 * c + 4] * sc, x[8 * c + 5] * sc); w.w = pk2(x[8 * c + 6] * sc, x[8 * c + 7] * sc); dst[c] = w; } }
        }
        { u32x2* p = (u32x2*)(Pr + 1024 + 12 * lane); float x[12];
#pragma unroll
          for (int c = 0; c < 3; ++c) { const u32x2 w = p[c]; x[4 * c] = bflo(w.x); x[4 * c + 1] = bfhi(w.x); x[4 * c + 2] = bflo(w.y); x[4 * c + 3] = bfhi(w.y); }
          float ss = 0.f;
#pragma unroll
          for (int i = 0; i < 12; ++i) ss += x[i] * x[i];
          const float rstd = 1.0f / sqrtf(wave_sum(ss, lane) * (1.0f / 768.0f) + EPS);
#pragma unroll
          for (int c = 0; c < 3; ++c) { const float* g = cqn + 12 * lane + 4 * c; u32x2 w; w.x = pk2(x[4 * c] * rstd * g[0], x[4 * c + 1] * rstd * g[1]); w.y = pk2(x[4 * c + 2] * rstd * g[2], x[4 * c + 3] * rstd * g[3]); p[c] = w; } }
        { u32x2* p = (u32x2*)(Pr + 3072 + 4 * lane); const u32x2 w = p[0]; float x0 = bflo(w.x), x1 = bfhi(w.x), x2 = bflo(w.y), x3 = bfhi(w.y);
          const float rstd = 1.0f / sqrtf(wave_sum(x0 * x0 + x1 * x1 + x2 * x2 + x3 * x3, lane) * (1.0f / 256.0f) + EPS);
          const float* g = ckn + 4 * lane; u32x2 o; o.x = pk2(x0 * rstd * g[0], x1 * rstd * g[1]); o.y = pk2(x2 * rstd * g[2], x3 * rstd * g[3]); p[0] = o; }
        { float x[32]; const u32x4* src = (const u32x4*)(Pr + 3328);
#pragma unroll
          for (int c = 0; c < 4; ++c) { const u32x4 w = src[c]; x[8 * c] = bflo(w.x); x[8 * c + 1] = bfhi(w.x); x[8 * c + 2] = bflo(w.y); x[8 * c + 3] = bfhi(w.y); x[8 * c + 4] = bflo(w.z); x[8 * c + 5] = bfhi(w.z); x[8 * c + 6] = bflo(w.w); x[8 * c + 7] = bfhi(w.w); }
          if (lat) {
#pragma unroll
              for (int hf = 0; hf < 2; ++hf) { const int pos = hf ? cpos : rpos;
#pragma unroll
                  for (int i = 0; i < 8; ++i) { const float c = RM[pos * 8 + i], s = RM[512 + pos * 8 + i]; const float x1 = x[16 * hf + i], x2 = x[16 * hf + 8 + i];
                      x[16 * hf + i] = x1 * c - x2 * s; x[16 * hf + 8 + i] = x2 * c + x1 * s; } }
          }
          if (lane < 8) { u32x4* dst = (u32x4*)(KC + (size_t)r * 768 + lane * 96 + 64);
#pragma unroll
              for (int c = 0; c < 4; ++c) { u32x4 w; w.x = pk2(x[8 * c], x[8 * c + 1]); w.y = pk2(x[8 * c + 2], x[8 * c + 3]); w.z = pk2(x[8 * c + 4], x[8 * c + 5]); w.w = pk2(x[8 * c + 6], x[8 * c + 7]); dst[c] = w; } } }
    }
}

__device__ __forceinline__ void moe_epan(const Ptrs& A, volatile LAS int* epan) {
    if (threadIdx.x == 0) { unsigned* ctl = (unsigned*)(A.ws + WS_CTL); int acc = 0; epan[0] = 0;
        for (int e = 0; e < 8; ++e) { const unsigned c = __hip_atomic_load(ctl + CW_MOE + 64 * e, __ATOMIC_RELAXED, __HIP_MEMORY_SCOPE_AGENT); acc += (int)((c + 255u) >> 8); epan[e + 1] = acc; } }
    __syncthreads();
}
__device__ __forceinline__ void scatter_phase(const Ptrs& A, volatile LAS int* epan, int vcu, int G) {
    const int tid = opaque_tid(), lane = tid & 63, wave = tid >> 6;
    const bf16_t* U = (const bf16_t*)(A.ws + WS_U); bf16_t* U2S = (bf16_t*)(A.ws + WS_U2S); int* rt = (int*)(A.ws + WS_ROUTE);
    const int gw = vcu * 8 + wave, NGW = G * 8;
    for (int i = gw; i < NLAT; i += NGW) {
        const int r = (i / SEQ) * SK + CTXL + (i % SEQ);
        const GAS u32x4* src = (const GAS u32x4*)(U + (size_t)r * DM) + lane;
        u32x4 v[4];
#pragma unroll
        for (int j = 0; j < 4; ++j) v[j] = src[64 * j];
#pragma unroll
        for (int k = 0; k < 2; ++k) { const int e = rt[RO_E + k * NLAT + i], slot = rt[RO_SLOT + k * NLAT + i]; const int dest = epan[e] * 256 + slot;
            GAS u32x4* dst = (GAS u32x4*)(U2S + (size_t)dest * DM) + lane;
#pragma unroll
            for (int j = 0; j < 4; ++j) dst[64 * j] = v[j];
            if (lane == 0) rt[RO_POS + k * NLAT + i] = dest; }
    }
}
__device__ __forceinline__ void final_phase(const Ptrs& A, int vcu, int G) {
    const int tid = opaque_tid(), lane = tid & 63, wave = tid >> 6;
    const float* H = (const float*)(A.ws + WS_H); const bf16_t* Y = (const bf16_t*)(A.ws + WS_Y); const int* rt = (const int*)(A.ws + WS_ROUTE);
    const float* MOD = (const float*)(A.ws + WS_CONST) + CO_MOD + (size_t)1 * 5 * 12288 + 5 * 2048;
    const float* gf = A.in[8];
    const int gw = vcu * 8 + wave, NGW = G * 8;
    for (int i = gw; i < NLAT; i += NGW) {
        const int b = i / SEQ, r = b * SK + CTXL + (i % SEQ);
        const int p0 = rt[RO_POS + i], p1 = rt[RO_POS + NLAT + i]; const float g0 = ((const float*)rt)[RO_GATE + i], g1 = ((const float*)rt)[RO_GATE + NLAT + i];
        const GAS f32x4* hr = (const GAS f32x4*)(H + (size_t)r * DM) + lane;
        const GAS u32x2* y0 = (const GAS u32x2*)(Y + (size_t)p0 * DM) + lane; const GAS u32x2* y1 = (const GAS u32x2*)(Y + (size_t)p1 * DM) + lane;
        const float* gt = MOD + (size_t)b * 12288;
        f32x4 v[8]; float ss = 0.f;
#pragma unroll
        for (int j = 0; j < 8; ++j) { const int c = 4 * lane + 256 * j; const f32x4 h4 = hr[64 * j], t4 = *(const f32x4*)(gt + c); const u32x2 a = y0[64 * j], bb = y1[64 * j];
            f32x4 ya, yb; ya.x = bflo(a.x); ya.y = bfhi(a.x); ya.z = bflo(a.y); ya.w = bfhi(a.y); yb.x = bflo(bb.x); yb.y = bfhi(bb.x); yb.z = bflo(bb.y); yb.w = bfhi(bb.y);
            v[j] = h4 + t4 * (ya * g0 + yb * g1);
            ss += (v[j].x * v[j].x + v[j].y * v[j].y) + (v[j].z * v[j].z + v[j].w * v[j].w); }
        const float rstd = 1.0f / sqrtf(wave_sum(ss, lane) * (1.0f / DM) + EPS);
        GAS f32x4* o = (GAS f32x4*)(A.out + (size_t)i * DM) + lane;
#pragma unroll
        for (int j = 0; j < 8; ++j) { const f32x4 g4 = *(const f32x4*)(gf + 4 * lane + 256 * j); o[64 * j] = v[j] * rstd * g4; }
    }
}

constexpr int N_PHASES = 22;
__global__ void __launch_bounds__(512, 2) fwd_kernel(Args args) {
    extern __shared__ __attribute__((aligned(16))) unsigned char lds_raw[];
    LAS unsigned char* lds = (LAS unsigned char*)lds_raw;
    volatile LAS unsigned* MISC = (volatile LAS unsigned*)(lds + MISC_OFF);
    volatile LAS int* epan = (volatile LAS int*)(lds + MISC_OFF + 64);
    const int tid = opaque_tid();
    const int G = gridDim.x, bx = blockIdx.x;
    const int vcu = (G % 8 == 0) ? (bx % 8) * (G / 8) + bx / 8 : bx;
    const Args& A = args;
    for (int u = tid; u < (LDS_BYTES - LDSCTL_OFF) / 4; u += 512) ((LAS unsigned*)(lds + LDSCTL_OFF))[u] = 0u;
    __syncthreads();
    const int lo = args.ph_lo, hi = args.ph_hi;
    unsigned* ctl = (unsigned*)(args.ws + WS_CTL);
    XcdBarrier bar; bar.bar = ctl + CW_BAR; bar.x = 0; bar.st = nullptr;
    const bool use_bar = (hi - lo) > 1;
    if (use_bar) bar = xcd_barrier_post(ctl + CW_BAR, MISC + 8);
#ifndef PHASE_MASK
#define PHASE_MASK 0xFFFu
#endif
#define EN(j) (((PHASE_MASK) >> (j)) & 1u)
#define IN(k) (lo <= (k) && (k) < hi)
#define SEAM(k) do { if (IN((k) + 1)) xcd_barrier(bar); } while (0)

    if (EN(0) && IN(0)) { p0_prologue(A, lds, vcu, G); __syncthreads(); SEAM(0); }

#define WSP(T, off) ((T*)(opaque_ws(args.ws) + (off)))

    for (int l = 0; l < 2; ++l) {
        const int pb = 1 + 10 * l;
        if (EN(1) && IN(pb + 0)) { norm_phase(A, l, 0, false, vcu, G); SEAM(pb + 0); }
        if (EN(2) && IN(pb + 1)) {
            pg8::Gemm g{WSP(bf16_t, WS_U), (const bf16_t*)(opaque_ws(args.ws) + WS_WIN) + (size_t)l * INW * 2048, DM, DM};
            pg8::Sched S; S.init(NPANEL, 17, G, bx, 0, nullptr);
            epi::EpiInProj E{WSP(bf16_t, WS_P), WSP(bf16_t, WS_VT)};
            pg8::gemm_phase<epi::EpiInProj, pg8::Sched, true, true>(lds, g, S, E);
            SEAM(pb + 1);
        }
        if (EN(3) && IN(pb + 2)) { post_phase(A, l, vcu, G); SEAM(pb + 2); }
        if (EN(4) && IN(pb + 3)) {
#ifndef MLA_MASK
#define MLA_MASK 3
#endif
            if (MLA_MASK & 1) { pg8::Gemm g{WSP(bf16_t, WS_P) + 1024, (const bf16_t*)(opaque_ws(args.ws) + WS_WQUP) + (size_t)l * 768 * 768, PW, 768};
              pg8::Sched S; S.init(l == 0 ? NPANEL : 64, 3, G, bx, l == 0 ? 0 : 1, nullptr);
              epi::EpiQup E{WSP(bf16_t, WS_QC), WSP(const float, WS_CONST) + CO_ROPEM, QS96};
              pg8::gemm_phase<epi::EpiQup, pg8::Sched, true, true>(lds, g, S, E); }
            __syncthreads();
            if (MLA_MASK & 2) { pg8::Gemm g{WSP(bf16_t, WS_P) + 3072, (const bf16_t*)(opaque_ws(args.ws) + WS_WKVUP) + (size_t)l * 1024 * 256, PW, 256};
              pg8::Sched S; S.init(NPANEL, 4, G, (bx + 128) % G, 0, nullptr);
              epi::EpiKVup E{WSP(bf16_t, WS_KC), WSP(bf16_t, WS_VT)};
              pg8::gemm_phase<epi::EpiKVup, pg8::Sched, true, true>(lds, g, S, E); }
            SEAM(pb + 3);
        }
        if (EN(5) && IN(pb + 4)) {
            att::Tensors T{WSP(bf16_t, WS_P), WSP(bf16_t, WS_QC), WSP(bf16_t, WS_KC), WSP(bf16_t, WS_VT), WSP(bf16_t, WS_O), A.in[15] + l * 128, A.in[22] + l * 8, WSP(const float, WS_CONST)[CO_LAM + l], l == 0 ? 0.8f : (1.0f - 0.35550906759096926f)};
            att::attn_phase(lds, T, vcu, G, bx, l == 0);
            SEAM(pb + 4);
        }
        if (EN(6) && IN(pb + 5)) {
            pg8::Gemm g{WSP(bf16_t, WS_O), (const bf16_t*)(opaque_ws(args.ws) + WS_WOUT) + (size_t)l * 2048 * 2048, DM, DM};
            pg8::Sched S; S.init(l == 0 ? NPANEL : 64, 8, G, bx, l == 0 ? 0 : 1, nullptr);
            epi::EpiResidOrY E{WSP(float, WS_H), WSP(const float, WS_CONST) + CO_MOD + (size_t)l * 5 * 12288 + 2 * 2048, nullptr, 0};
            pg8::gemm_phase<epi::EpiResidOrY, pg8::Sched, true, true>(lds, g, S, E);
            SEAM(pb + 5);
        }
        if (EN(7) && IN(pb + 6)) { norm_phase(A, l, 1, l == 1, vcu, G); SEAM(pb + 6); }
        if (EN(8) && l == 1 && IN(pb + 7)) { moe_epan(A, epan); scatter_phase(A, epan, vcu, G); SEAM(pb + 7); }
        if (EN(9) && IN(pb + 8)) {
            int npan = NPANEL;
            if (l == 1) { moe_epan(A, epan); npan = epan[8]; }
            pg8::Gemm g{l == 0 ? WSP(const bf16_t, WS_U) : WSP(const bf16_t, WS_U2S), (const bf16_t*)(opaque_ws(args.ws) + (l == 0 ? WS_WGU0 : WS_WGU1)), DM, DM};
            pg8::Sched S; S.init(npan, NGU_T, G, bx, 0, l == 0 ? nullptr : (const LAS int*)epan);
            epi::EpiGU E{WSP(bf16_t, WS_ACT)};
            pg8::gemm_phase<epi::EpiGU, pg8::Sched, true, true>(lds, g, S, E);
            SEAM(pb + 8);
        }
        if (EN(10) && IN(pb + 9)) {
            int npan = NPANEL;
            if (l == 1) { moe_epan(A, epan); npan = epan[8]; }
            pg8::Gemm g{WSP(bf16_t, WS_ACT), (const bf16_t*)(opaque_ws(args.ws) + (l == 0 ? WS_WDN0 : WS_WDN1)), FF, FF};
            pg8::Sched S; S.init(npan, 8, G, bx, 0, l == 0 ? nullptr : (const LAS int*)epan);
            epi::EpiResidOrY E{WSP(float, WS_H), WSP(const float, WS_CONST) + CO_MOD + (size_t)l * 5 * 12288 + 5 * 2048, WSP(bf16_t, WS_Y), l};
            pg8::gemm_phase<epi::EpiResidOrY, pg8::Sched, true, true>(lds, g, S, E);
            SEAM(pb + 9);
        }
    }
    if (EN(11) && IN(21)) final_phase(A, vcu, G);
#undef IN
#undef SEAM
}

#ifndef MK_PER_PHASE
#define MK_PER_PHASE 0
#endif
extern "C" void kernel_launch(void* const* d_in, const int* in_sizes, int n_in, void* d_out, int out_size, void* d_ws, size_t ws_size, hipStream_t stream) {
    static int grid = 0;
    if (grid == 0) {
        if (n_in != 31 || out_size != NLAT * DM || ws_size < WS_END) { fprintf(stderr, "kernel_launch: unexpected shapes (n_in %d, out %d, ws %zu < %zu); nothing launched\n", n_in, out_size, ws_size, (size_t)WS_END); grid = -1; return; }
        int dev = 0, cus = 0, per_cu = 0;
        if (hipGetDevice(&dev) != hipSuccess || hipDeviceGetAttribute(&cus, hipDeviceAttributeMultiprocessorCount, dev) != hipSuccess) { grid = -1; return; }
        if (hipFuncSetAttribute((const void*)fwd_kernel, hipFuncAttributeMaxDynamicSharedMemorySize, LDS_BYTES) != hipSuccess) { fprintf(stderr, "kernel_launch: hipFuncSetAttribute failed\n"); grid = -1; return; }
        if (hipOccupancyMaxActiveBlocksPerMultiprocessor(&per_cu, (const void*)fwd_kernel, 512, LDS_BYTES) != hipSuccess || per_cu < 1) { fprintf(stderr, "kernel_launch: occupancy query reports %d blocks per CU\n", per_cu); (void)hipGetLastError(); grid = -1; return; }
        grid = cus;
    }
    if (grid < 0) return;
    (void)hipMemsetAsync((char*)d_ws + WS_CTL, 0, CTL_ZERO_BYTES, stream);
    Args a{};
    for (int i = 0; i < 31; ++i) a.in[i] = (const float*)d_in[i];
    a.out = (float*)d_out; a.ws = (unsigned char*)d_ws;
#if MK_PER_PHASE
    for (int p = 0; p < N_PHASES; ++p) { if (p == 8) continue; a.ph_lo = p; a.ph_hi = p + 1; hipLaunchKernelGGL(fwd_kernel, dim3(grid), dim3(512), LDS_BYTES, stream, a); }
#else
    a.ph_lo = 0; a.ph_hi = N_PHASES;
    hipLaunchKernelGGL(fwd_kernel, dim3(grid), dim3(512), LDS_BYTES, stream, a);
#endif
}
```

```cpp
#include <hip/hip_runtime.h>
#include <cstdint>
#include <cstdio>

#define GAS __attribute__((address_space(1)))
#define LAS __attribute__((address_space(3)))
#define PG8_LAS LAS
typedef unsigned short bf16_t;
typedef short bf16x8 __attribute__((ext_vector_type(8)));
typedef float f32x4 __attribute__((ext_vector_type(4)));
typedef float f32x2 __attribute__((ext_vector_type(2)));
typedef float f32x16 __attribute__((ext_vector_type(16)));
typedef unsigned u32x4 __attribute__((ext_vector_type(4)));
typedef unsigned u32x2 __attribute__((ext_vector_type(2)));
typedef __bf16 bf16x2_t __attribute__((ext_vector_type(2)));
typedef GAS unsigned gu32;

constexpr int DM = 2048, NBATCH = 4, SEQ = 4096, CTXL = 256;
constexpr int SK = SEQ + CTXL;
constexpr int MR = NBATCH * SK;
constexpr int NPANEL = MR / 256;
constexpr int IN_SRC = 4128;
constexpr int INW = 4352;
constexpr int PW = 3584;
constexpr int FF = 5632, NEXP = 8, NGU_T = 44;
constexpr int VT_ROWS = 1280;
constexpr int RS_MAX = 34816;
constexpr int NLAT = NBATCH * SEQ;
constexpr float EPS = 1e-6f;
constexpr float LOG2E = 1.4426950408889634f;
constexpr float QS64 = 0.125f * LOG2E;
constexpr float QS96 = 0.10206207261596575f * LOG2E;

constexpr size_t MiB = 1u << 20;
constexpr size_t WS_CTL = 0, CTL_ZERO_BYTES = 1 * MiB;
constexpr size_t WS_CONST = 1 * MiB;
constexpr size_t WS_ROUTE = 2 * MiB;
constexpr size_t WS_WIN = 3 * MiB;
constexpr size_t WS_WOUT = WS_WIN + 34 * MiB;
constexpr size_t WS_WQUP = WS_WOUT + 16 * MiB;
constexpr size_t WS_WKVUP = WS_WQUP + 3 * MiB;
constexpr size_t WS_WGU0 = WS_WKVUP + 1 * MiB;
constexpr size_t WS_WDN0 = WS_WGU0 + 44 * MiB;
constexpr size_t WS_WGU1 = WS_WDN0 + 22 * MiB;
constexpr size_t WS_WDN1 = WS_WGU1 + 352 * MiB;
constexpr size_t WS_H = WS_WDN1 + 176 * MiB;
constexpr size_t WS_U = WS_H + 136 * MiB;
constexpr size_t WS_Z = WS_U + 68 * MiB;
constexpr size_t WS_P = WS_Z;
constexpr size_t WS_VT = WS_P + 119 * MiB;
constexpr size_t WS_KC = WS_VT + 43 * MiB;
constexpr size_t WS_QC = WS_KC + 26 * MiB;
constexpr size_t WS_O = WS_QC + 26 * MiB;
constexpr size_t WS_U2S = WS_Z;
constexpr size_t WS_Y = WS_Z + 136 * MiB;
constexpr size_t WS_ACT = WS_Z + 282 * MiB;
constexpr size_t WS_PART = WS_ACT + 374 * MiB;
constexpr size_t WS_END = WS_PART + 64 * MiB;
static_assert(WS_O + (size_t)MR * DM * 2 <= WS_ACT && WS_Y + (size_t)RS_MAX * DM * 2 <= WS_ACT, "region Z");
static_assert((size_t)RS_MAX * FF * 2 <= 374 * MiB && (size_t)MR * PW * 2 <= 119 * MiB && (size_t)NBATCH * VT_ROWS * SK * 2 <= 43 * MiB, "sizes");
static_assert((size_t)2 * INW * DM * 2 <= 34 * MiB && (size_t)8 * 11264 * 2048 * 2 <= 352 * MiB && (size_t)8 * 2048 * 5632 * 2 <= 176 * MiB, "weights");

constexpr int CO_MOD = 0;
constexpr int CO_ROPEH = 2 * 5 * 12288;
constexpr int CO_ROPEM = CO_ROPEH + 2048;
constexpr int CO_LAM = CO_ROPEM + 1024;
constexpr int RO_E = 0, RO_SLOT = 2 * NLAT, RO_GATE = 4 * NLAT, RO_POS = 6 * NLAT;
static_assert((size_t)8 * NLAT * 4 <= 1 * MiB, "route");
constexpr int CW_TMO = 0, CW_CODE = 1, CW_BAR = 4096, CW_MOE = 16384;

constexpr int RING_BYTES = 131072;
constexpr int LDSCTL_OFF = RING_BYTES, MISC_OFF = LDSCTL_OFF + 320;
constexpr int LDS_BYTES = 147456;

__device__ __forceinline__ unsigned pk2(float lo, float hi) { f32x2 v = {lo, hi}; bf16x2_t b = __builtin_convertvector(v, bf16x2_t); return __builtin_bit_cast(unsigned, b); }
__device__ __forceinline__ float bflo(unsigned w) { return __uint_as_float(w << 16); }
__device__ __forceinline__ float bfhi(unsigned w) { return __uint_as_float(w & 0xffff0000u); }
__device__ __forceinline__ float shfl_xor_l(float v, int mask, int lane) { return __int_as_float(__builtin_amdgcn_ds_bpermute((lane ^ mask) << 2, __float_as_int(v))); }
__device__ __forceinline__ float wave_sum(float v, int lane) {
#pragma unroll
    for (int o = 1; o < 64; o <<= 1) v += shfl_xor_l(v, o, lane);
    return v;
}
__device__ __forceinline__ float xsum32(float a) { auto rr = __builtin_amdgcn_permlane32_swap(__float_as_uint(a), __float_as_uint(a), false, false); return __uint_as_float(rr[0]) + __uint_as_float(rr[1]); }
__device__ __forceinline__ float xmax32(float a) { auto rr = __builtin_amdgcn_permlane32_swap(__float_as_uint(a), __float_as_uint(a), false, false); return fmaxf(__uint_as_float(rr[0]), __uint_as_float(rr[1])); }
__device__ __forceinline__ float silu_f(float x) { return x * __builtin_amdgcn_rcpf(1.0f + __builtin_amdgcn_exp2f(-x * LOG2E)); }
__device__ __forceinline__ unsigned char* opaque_ws(unsigned char* p) { asm volatile("" : "+s"(p)); return p; }
__device__ __forceinline__ int opaque_tid() { int t = threadIdx.x; asm volatile("" : "+v"(t)); return t; }
#define LDS_WAIT() asm volatile("s_waitcnt lgkmcnt(0)" ::: "memory")

namespace pg8 {
constexpr int BM = 256, BK = 64, HALF = 128, HTB = HALF * BK * 2, STAGE_BYTES = 8 * HTB, NXCD = 8, WGM = 8;
__host__ __device__ __forceinline__ int lds_byte(int r, int c) { const int st = (r >> 4) * 2 + (c >> 5), rr = r & 15, cc = c & 31, ob = rr * 64 + cc * 2; return st * 1024 + (ob ^ (((ob >> 9) & 1) << 5)); }
__host__ __device__ __forceinline__ void stage_rc(int b, int& R, int& C) { const int st = b / 1024, sb = b % 1024, swz = sb ^ (((sb >> 9) & 1) << 5); R = (st >> 1) * 16 + swz / 64; C = (st & 1) * 32 + (swz % 64) / 2; }
__host__ __device__ __forceinline__ int perm32(int rho) { const int n = rho >> 4, i = rho & 15; return 8 * (i >> 2) + 4 * n + (i & 3); }

struct Unit { int pm, pn, pb, kind, k0, nkt, ks; };
struct Gemm { const bf16_t* A; const bf16_t* Bt; const bf16_t* A2; const bf16_t* Bt2; int lda, ldb; };

struct Sched {
    int nM, nN, nwg0, nwg, G, c, pmode, t16, ntd, KT, tl_np, tl_S, tl_mode, tl_pm0; const LAS int* epan;
    __device__ __forceinline__ void init(int nM_, int nN_, int KT_, int G_, int c_, int pmode_, const LAS int* epan_, int t16_ = 0, int ntd_ = 1, int nT_ = 0) {
        nM = nM_; nN = nN_; KT = KT_; nwg0 = nM * nN; nwg = nwg0 + nT_; G = G_; c = c_; pmode = pmode_; epan = epan_; t16 = t16_; ntd = ntd_; tl_np = 0; tl_S = 1; tl_mode = 0; tl_pm0 = 0; }
    __device__ __forceinline__ void set_tail(int np, int S, int mode, int pm0) { tl_np = np; tl_S = S; tl_mode = mode; tl_pm0 = pm0; nwg += np * nN * S; }
    __device__ __forceinline__ int bs(int j) const { int v = (KT * j) >> 3; return v + (v & 1); }
    __device__ __forceinline__ int expert_of(int pm) const { int e = 0;
#pragma unroll
        for (int j = 1; j < 8; ++j) e += (pm >= epan[j]) ? 1 : 0;
        return e; }
    __device__ __forceinline__ bool next(int i, Unit& u) const {
        const long L = (long)i * G + c; if (L >= nwg) return false;
        u.k0 = 0; u.nkt = KT; u.ks = -1;
        const int nmain = nwg - tl_np * nN * tl_S;
        if (L >= nmain) {
            const int q = (int)L - nmain, ks = q % tl_S, uu = q / tl_S, pi = uu / nN, pn = uu % nN, pm = tl_mode ? tl_pm0 + pi : 17 * pi, sh = 8 / tl_S;
            u.kind = 0; u.pn = pn; u.pb = epan ? expert_of(pm) * nN + pn : pn; u.pm = pm; u.ks = ks; u.k0 = bs(ks * sh); u.nkt = bs((ks + 1) * sh) - u.k0; return true; }
        int wgid = (int)L; { const int q = nmain / NXCD, r = nmain % NXCD, xcd = wgid % NXCD, off = wgid / NXCD; wgid = (xcd < r ? xcd * (q + 1) : r * (q + 1) + (xcd - r) * q) + off; }
        if (wgid >= nwg0) { const int q = wgid - nwg0; u.kind = 1; u.pm = q % ntd; u.pn = q / ntd; u.pb = u.pn; return true; }
        const int nig = WGM * nN, gid = wgid / nig, fm = gid * WGM, gsz = (nM - fm) < WGM ? (nM - fm) : WGM;
        int pm = fm + ((wgid % nig) % gsz); const int pn = (wgid % nig) / gsz;
        u.kind = 0; u.pn = pn; u.pb = (t16 && pn == 13) ? 16 : pn;
        if (epan) u.pb = expert_of(pm) * nN + pn;
        if (pmode == 1) pm = pm + pm / 16 + 1;
        u.pm = pm; return true;
    }
    __device__ __forceinline__ void a_ready(const Unit&) const {}
    __device__ __forceinline__ void done(const Unit&) const {}
};

template <class Epi, class Sched, bool ALIGN_EPI = false, bool SP2 = false>
__device__ __forceinline__ void gemm_phase(PG8_LAS unsigned char* lds, const Gemm g, const Sched& S, const Epi& E) {
    const int tid = opaque_tid(), wid = __builtin_amdgcn_readfirstlane(tid >> 6), lane = tid & 63, wr = wid >> 2, wc = wid & 3, fr = lane & 15, fq = lane >> 4;
    unsigned voffA[2], voffB[2];
#pragma unroll
    for (int i = 0; i < 2; ++i) { int R, C; stage_rc(tid * 16 + i * 8192, R, C); const int Rb = Epi::PERM ? ((R & ~31) + perm32(R & 31)) : R;
        voffA[i] = (unsigned)(R * g.lda + C) * 2u; voffB[i] = (unsigned)(Rb * g.ldb + C) * 2u; }
    const size_t kstep = (size_t)(BK * 2);
    const size_t hstepA = (size_t)HALF * g.lda * 2, hstepB = (size_t)HALF * g.ldb * 2;
    const size_t tstepA = 2 * hstepA, tstepB = 2 * hstepB;
    const unsigned ldsw = (unsigned)wid * 1024u;
    const int aoff = lds_byte(wr * 64 + fr, fq * 8), boff = lds_byte(wc * 32 + fr, fq * 8);
#define PG8_SA(b, h) (((b) * 2 + (h)) * HTB)
#define PG8_SB(b, h) ((4 + (b) * 2 + (h)) * HTB)
#define PG8_STAGE(bufoff, gbase, voff) do { _Pragma("unroll") for (int _i = 0; _i < 2; ++_i) \
        __builtin_amdgcn_global_load_lds((const unsigned*)((const char*)(gbase) + (voff)[_i]), (PG8_LAS unsigned*)(lds + (bufoff) + ldsw + _i * 8192), 16, 0, 0); } while (0)
#define PG8_LDA(dst, b, h) do { _Pragma("unroll") for (int m = 0; m < 4; ++m) _Pragma("unroll") for (int k = 0; k < 2; ++k) dst[m][k] = *(const PG8_LAS bf16x8*)(lds + PG8_SA(b, h) + aoff + m * 2048 + k * 1024); } while (0)
#define PG8_LDB(dst, b, h) do { _Pragma("unroll") for (int n = 0; n < 2; ++n) _Pragma("unroll") for (int k = 0; k < 2; ++k) dst[n][k] = *(const PG8_LAS bf16x8*)(lds + PG8_SB(b, h) + boff + n * 2048 + k * 1024); } while (0)
#define PG8_MMA(ai, bj, At, Bt) do { __builtin_amdgcn_s_setprio(1); _Pragma("unroll") for (int m = 0; m < 4; ++m) _Pragma("unroll") for (int n = 0; n < 2; ++n) _Pragma("unroll") for (int k = 0; k < 2; ++k) \
        acc[ai][bj][m][n] = __builtin_amdgcn_mfma_f32_16x16x32_bf16(Bt[n][k], At[m][k], acc[ai][bj][m][n], 0, 0, 0); __builtin_amdgcn_s_setprio(0); } while (0)
#define PG8_WAIT_V(n) asm volatile("s_waitcnt vmcnt(" #n ")" ::: "memory")
#define PG8_WAIT_L(n) asm volatile("s_waitcnt lgkmcnt(" #n ")" ::: "memory")
#define PG8_BAR __builtin_amdgcn_s_barrier()
#define PG8_SCHED __builtin_amdgcn_sched_barrier(0)
    Unit cur, nxt; int ui = 0;
    if (!S.next(0, cur)) return;
    f32x4 acc[2][2][4][2];
#pragma unroll
    for (int a = 0; a < 2; ++a)
#pragma unroll
        for (int b = 0; b < 2; ++b)
#pragma unroll
            for (int m = 0; m < 4; ++m)
#pragma unroll
                for (int n = 0; n < 2; ++n) acc[a][b][m][n] = (f32x4){0.f, 0.f, 0.f, 0.f};
    bf16x8 At[4][2], B0[2][2], B1[2][2];
    int nt = cur.nkt;
    const char* cA = (const char*)(cur.kind ? g.A2 : g.A) + (size_t)cur.pm * tstepA + (size_t)cur.k0 * kstep; const char* cB = (const char*)(cur.kind ? g.Bt2 : g.Bt) + (size_t)cur.pb * tstepB + (size_t)cur.k0 * kstep;
    S.a_ready(cur);
    if constexpr (SP2) {
        PG8_STAGE(PG8_SB(0, 0), cB, voffB); PG8_STAGE(PG8_SB(0, 1), cB + hstepB, voffB); PG8_STAGE(PG8_SA(0, 0), cA, voffA); PG8_STAGE(PG8_SA(0, 1), cA + hstepA, voffA);
        if (wr == 1) PG8_BAR;
        PG8_WAIT_V(2); PG8_BAR;
        PG8_STAGE(PG8_SB(1, 0), cB + kstep, voffB); PG8_STAGE(PG8_SA(1, 0), cA + kstep, voffA); PG8_STAGE(PG8_SB(1, 1), cB + hstepB + kstep, voffB);
        PG8_WAIT_V(6); PG8_BAR;
    } else {
        PG8_STAGE(PG8_SB(0, 0), cB, voffB); PG8_STAGE(PG8_SA(0, 0), cA, voffA); PG8_STAGE(PG8_SB(0, 1), cB + hstepB, voffB); PG8_STAGE(PG8_SA(0, 1), cA + hstepA, voffA);
        if (wr == 1) PG8_BAR;
        PG8_WAIT_V(4); PG8_BAR;
        PG8_STAGE(PG8_SB(1, 0), cB + kstep, voffB); PG8_STAGE(PG8_SA(1, 0), cA + kstep, voffA); PG8_STAGE(PG8_SB(1, 1), cB + hstepB + kstep, voffB);
        PG8_WAIT_V(6); PG8_BAR;
    }
    for (;;) {
        const bool has_next = S.next(ui + 1, nxt);
        const char* nA = has_next ? (const char*)(nxt.kind ? g.A2 : g.A) + (size_t)nxt.pm * tstepA + (size_t)nxt.k0 * kstep : cA; const char* nB = has_next ? (const char*)(nxt.kind ? g.Bt2 : g.Bt) + (size_t)nxt.pb * tstepB + (size_t)nxt.k0 * kstep : cB;
        for (int t = 0; t < nt; t += 2) {
            const bool last = (t == nt - 2);
            const char* a1 = cA + (size_t)(t + 1) * kstep;
            const char* a2 = last ? nA : cA + (size_t)(t + 2) * kstep; const char* b2 = last ? nB : cB + (size_t)(t + 2) * kstep;
            const char* a3 = a2 + kstep; const char* b3 = b2 + kstep;
            if (last && has_next) S.a_ready(nxt);
            if constexpr (SP2) {
            PG8_LDB(B0, 0, 0); PG8_LDB(B1, 0, 1); PG8_SCHED; PG8_LDA(At, 0, 0); PG8_STAGE(PG8_SA(1, 1), a1 + hstepA, voffA);
            PG8_WAIT_V(8); PG8_WAIT_L(0); PG8_BAR; PG8_MMA(0, 0, At, B0); PG8_MMA(0, 1, At, B1); PG8_BAR; PG8_SCHED;
            PG8_LDA(At, 0, 1); PG8_STAGE(PG8_SB(0, 0), b2, voffB); PG8_STAGE(PG8_SB(0, 1), b2 + hstepB, voffB); PG8_STAGE(PG8_SA(0, 0), a2, voffA);
            PG8_WAIT_V(8); PG8_WAIT_L(0); PG8_BAR; PG8_MMA(1, 0, At, B0); PG8_MMA(1, 1, At, B1); PG8_BAR; PG8_SCHED;
            PG8_LDB(B0, 1, 0); PG8_LDB(B1, 1, 1); PG8_SCHED; PG8_LDA(At, 1, 0); PG8_STAGE(PG8_SA(0, 1), a2 + hstepA, voffA);
            PG8_WAIT_V(8); PG8_WAIT_L(0); PG8_BAR; PG8_MMA(0, 0, At, B0); PG8_MMA(0, 1, At, B1); PG8_BAR; PG8_SCHED;
            PG8_LDA(At, 1, 1); PG8_STAGE(PG8_SB(1, 0), b3, voffB); PG8_STAGE(PG8_SB(1, 1), b3 + hstepB, voffB); PG8_STAGE(PG8_SA(1, 0), a3, voffA);
            PG8_WAIT_V(8); PG8_WAIT_L(0); PG8_BAR; PG8_MMA(1, 0, At, B0); PG8_MMA(1, 1, At, B1); PG8_BAR; PG8_SCHED;
            } else {
            PG8_LDB(B0, 0, 0); PG8_SCHED; PG8_LDA(At, 0, 0); PG8_STAGE(PG8_SA(1, 1), a1 + hstepA, voffA);
            PG8_WAIT_L(8); PG8_BAR; PG8_WAIT_L(0); PG8_MMA(0, 0, At, B0); PG8_BAR; PG8_SCHED;
            PG8_LDB(B1, 0, 1); PG8_STAGE(PG8_SB(0, 0), b2, voffB);
            PG8_BAR; PG8_WAIT_L(0); PG8_MMA(0, 1, At, B1); PG8_BAR;
            PG8_LDA(At, 0, 1); PG8_STAGE(PG8_SA(0, 0), a2, voffA);
            PG8_BAR; PG8_WAIT_L(0); PG8_MMA(1, 0, At, B0); PG8_BAR; PG8_SCHED;
            PG8_STAGE(PG8_SB(0, 1), b2 + hstepB, voffB);
            PG8_WAIT_V(6); PG8_BAR; PG8_MMA(1, 1, At, B1); PG8_BAR;
            PG8_LDB(B0, 1, 0); PG8_SCHED; PG8_LDA(At, 1, 0); PG8_STAGE(PG8_SA(0, 1), a2 + hstepA, voffA);
            PG8_WAIT_L(8); PG8_BAR; PG8_WAIT_L(0); PG8_MMA(0, 0, At, B0); PG8_BAR; PG8_SCHED;
            PG8_LDB(B1, 1, 1); PG8_STAGE(PG8_SB(1, 0), b3, voffB);
            PG8_BAR; PG8_WAIT_L(0); PG8_MMA(0, 1, At, B1); PG8_BAR;
            PG8_LDA(At, 1, 1); PG8_STAGE(PG8_SA(1, 0), a3, voffA);
            PG8_BAR; PG8_WAIT_L(0); PG8_MMA(1, 0, At, B0); PG8_BAR; PG8_SCHED;
            PG8_STAGE(PG8_SB(1, 1), b3 + hstepB, voffB);
            PG8_WAIT_V(6); PG8_BAR; PG8_MMA(1, 1, At, B1); PG8_BAR;
            }
        }
        if constexpr (ALIGN_EPI) { if (wr == 0) PG8_BAR; }
        if constexpr (!Epi::AFTER_DRAIN) { E(acc, cur, wr, wc, fr, fq); S.done(cur); }
        if (!has_next) break;
#pragma unroll
        for (int a = 0; a < 2; ++a)
#pragma unroll
            for (int b = 0; b < 2; ++b)
#pragma unroll
                for (int m = 0; m < 4; ++m)
#pragma unroll
                    for (int n = 0; n < 2; ++n) acc[a][b][m][n] = (f32x4){0.f, 0.f, 0.f, 0.f};
        cur = nxt; cA = nA; cB = nB; ++ui; nt = cur.nkt;
        if constexpr (ALIGN_EPI) { if (wr == 1) PG8_BAR; }
    }
    PG8_WAIT_V(0);
    if constexpr (!ALIGN_EPI) { if (wr == 0) PG8_BAR; }
    PG8_BAR;
    if constexpr (Epi::AFTER_DRAIN) { E.fused(acc, cur, wr, wc, fr, fq, lds, wid, lane); S.done(cur); }
#undef PG8_SA
#undef PG8_SB
#undef PG8_STAGE
#undef PG8_LDA
#undef PG8_LDB
#undef PG8_MMA
#undef PG8_WAIT_V
#undef PG8_WAIT_L
#undef PG8_BAR
#undef PG8_SCHED
}

}

namespace epi {
using pg8::Unit;
typedef const f32x4 (&AccRef)[2][2][4][2];

__device__ __forceinline__ void store_vt_rows(AccRef acc, bf16_t* Vt, int vrow0, const Unit& u, int wr, int wc, int fr, int fq) {
    const int b = u.pn / 17, kk0 = (u.pn % 17) * 256 + wc * 32 + 8 * fq;
#pragma unroll
    for (int ai = 0; ai < 2; ++ai)
#pragma unroll
        for (int m = 0; m < 4; ++m) { bf16_t* rowp = Vt + ((size_t)b * VT_ROWS + vrow0 + u.pm * 256 + ai * 128 + wr * 64 + m * 16 + fr) * SK + kk0;
#pragma unroll
            for (int bj = 0; bj < 2; ++bj) { const f32x4 v0 = acc[ai][bj][m][0], v1 = acc[ai][bj][m][1];
                u32x4 w; w.x = pk2(v0[0], v0[1]); w.y = pk2(v0[2], v0[3]); w.z = pk2(v1[0], v1[1]); w.w = pk2(v1[2], v1[3]);
                *(u32x4*)(rowp + bj * 128) = w; } }
}

struct EpiInProj {
    static constexpr bool PERM = true, AFTER_DRAIN = false;
    bf16_t* P; bf16_t* Vt;
    __device__ __forceinline__ void operator()(AccRef acc, const Unit& u, int wr, int wc, int fr, int fq) const {
        { const int t_ = opaque_tid(); fr = t_ & 15; fq = (t_ >> 4) & 3; }
        if (u.kind) { store_vt_rows(acc, Vt, 0, u, wr, wc, fr, fq); }
        else {
            const int pcol = u.pn * 256 + wc * 32 + 8 * fq;
#pragma unroll
            for (int ai = 0; ai < 2; ++ai)
#pragma unroll
                for (int m = 0; m < 4; ++m) { bf16_t* rowp = P + (size_t)(u.pm * 256 + ai * 128 + wr * 64 + m * 16 + fr) * PW + pcol;
#pragma unroll
                    for (int bj = 0; bj < 2; ++bj) { const f32x4 v0 = acc[ai][bj][m][0], v1 = acc[ai][bj][m][1];
                        u32x4 w; w.x = pk2(v0[0], v0[1]); w.y = pk2(v0[2], v0[3]); w.z = pk2(v1[0], v1[1]); w.w = pk2(v1[2], v1[3]);
                        *(u32x4*)(rowp + bj * 128) = w; } }
        }
    }
};

struct EpiQup {
    static constexpr bool PERM = false, AFTER_DRAIN = false;
    bf16_t* QC; const float* tab; float scale;
    __device__ __forceinline__ void operator()(AccRef acc, const Unit& u, int wr, int wc, int fr, int fq) const {
        { const int t_ = opaque_tid(); fr = t_ & 15; fq = (t_ >> 4) & 3; }
        const bool is_lat = (u.pm % 17) != 0;
        const int kkb = (u.pm % 17) * 256 - 256 + wr * 64 + fr;
#pragma unroll
        for (int bj = 0; bj < 2; ++bj) {
            const int cb = 8 * u.pn + 4 * bj + wc; const bool rope = (cb % 3) == 2;
#pragma unroll
            for (int ai = 0; ai < 2; ++ai)
#pragma unroll
                for (int m = 0; m < 4; ++m) {
                    const int t = kkb + ai * 128 + m * 16;
                    bf16_t* rowp = QC + (size_t)(u.pm * 256 + ai * 128 + wr * 64 + m * 16 + fr) * 768 + u.pn * 256 + bj * 128 + wc * 32 + 4 * fq;
#pragma unroll
                    for (int n = 0; n < 2; ++n) {
                        f32x4 v = acc[ai][bj][m][n];
                        if (rope) {
                            const int ln = fq * 16 + fr; f32x4 p; p[0] = shfl_xor_l(v[0], 32, ln); p[1] = shfl_xor_l(v[1], 32, ln); p[2] = shfl_xor_l(v[2], 32, ln); p[3] = shfl_xor_l(v[3], 32, ln);
                            if (is_lat) {
                                const int pos = n ? (t & 63) : (t >> 6);
                                const f32x4 cs = *(const f32x4*)(tab + pos * 8 + 4 * (fq & 1)), sn = *(const f32x4*)(tab + 512 + pos * 8 + 4 * (fq & 1));
                                v = (fq < 2) ? (v * cs - p * sn) : (v * cs + p * sn);
                            }
                        }
                        v = v * scale;
                        u32x2 w; w.x = pk2(v[0], v[1]); w.y = pk2(v[2], v[3]);
                        *(u32x2*)(rowp + n * 16) = w;
                    }
                    asm volatile("" ::: "memory");
                }
        }
    }
};

struct EpiKC {
    static constexpr bool PERM = true, AFTER_DRAIN = false;
    bf16_t* KC;
    __device__ __forceinline__ void operator()(AccRef acc, const Unit& u, int wr, int wc, int fr, int fq) const {
        { const int t_ = opaque_tid(); fr = t_ & 15; fq = (t_ >> 4) & 3; }
#pragma unroll
        for (int ai = 0; ai < 2; ++ai)
#pragma unroll
            for (int m = 0; m < 4; ++m) { bf16_t* rowp = KC + (size_t)(u.pm * 256 + ai * 128 + wr * 64 + m * 16 + fr) * 768;
#pragma unroll
                for (int bj = 0; bj < 2; ++bj) { const int c = u.pn * 256 + bj * 128 + wc * 32 + 8 * fq; const f32x4 v0 = acc[ai][bj][m][0], v1 = acc[ai][bj][m][1];
                    u32x4 w; w.x = pk2(v0[0], v0[1]); w.y = pk2(v0[2], v0[3]); w.z = pk2(v1[0], v1[1]); w.w = pk2(v1[2], v1[3]);
                    *(u32x4*)(rowp + (c >> 6) * 96 + (c & 63)) = w; } }
    }
};
struct EpiVt {
    static constexpr bool PERM = true, AFTER_DRAIN = false;
    bf16_t* Vt; int vrow0;
    __device__ __forceinline__ void operator()(AccRef acc, const Unit& u, int wr, int wc, int fr, int fq) const {
        { const int t_ = opaque_tid(); fr = t_ & 15; fq = (t_ >> 4) & 3; }
        store_vt_rows(acc, Vt, vrow0, u, wr, wc, fr, fq);
    }
};

struct EpiResidOrY {
    static constexpr bool PERM = false, AFTER_DRAIN = false;
    float* H; const float* gate; bf16_t* Y; float* PART; const float* XIN; int mode, tl_rows, tl_pm0;
    __device__ __forceinline__ void operator()(AccRef acc, const Unit& u, int wr, int wc, int fr, int fq) const {
        { const int t_ = opaque_tid(); fr = t_ & 15; fq = (t_ >> 4) & 3; }
        const int col0 = u.pn * 256 + wc * 32 + 4 * fq;
        if (mode == 0) {
            const int modv = (u.pm % 17 == 0) ? 4 : u.pm / 17;
            const float* gv = gate + (size_t)modv * 12288 + col0;
            f32x4 g4[2][2];
#pragma unroll
            for (int bj = 0; bj < 2; ++bj)
#pragma unroll
                for (int n = 0; n < 2; ++n) g4[bj][n] = *(const f32x4*)(gv + bj * 128 + n * 16);
            if (u.ks >= 0) {
                float* pp = PART + ((size_t)u.ks * tl_rows + (u.pm / 17) * 256 + wr * 64 + fr) * DM + col0;
#pragma unroll
                for (int ai = 0; ai < 2; ++ai)
#pragma unroll
                    for (int m = 0; m < 4; ++m)
#pragma unroll
                        for (int bj = 0; bj < 2; ++bj)
#pragma unroll
                            for (int n = 0; n < 2; ++n) *(f32x4*)(pp + (size_t)(ai * 128 + m * 16) * DM + bj * 128 + n * 16) = g4[bj][n] * acc[ai][bj][m][n];
            } else {
                const int row0 = u.pm * 256 + wr * 64 + fr;
                const float* bp = XIN ? XIN + (size_t)((u.pm / 17) * SEQ + (u.pm % 17 - 1) * 256 + wr * 64 + fr) * DM + col0 : H + (size_t)row0 * DM + col0;
                float* hp = H + (size_t)row0 * DM + col0;
#pragma unroll
                for (int ai = 0; ai < 2; ++ai)
#pragma unroll
                    for (int m = 0; m < 4; ++m) { const size_t ro = (size_t)(ai * 128 + m * 16) * DM;
#pragma unroll
                        for (int bj = 0; bj < 2; ++bj)
#pragma unroll
                            for (int n = 0; n < 2; ++n) { f32x4 hv = *(const f32x4*)(bp + ro + bj * 128 + n * 16); hv = hv + g4[bj][n] * acc[ai][bj][m][n]; *(f32x4*)(hp + ro + bj * 128 + n * 16) = hv; }
                        if (m & 1) asm volatile("" ::: "memory"); }
            }
        } else {
            if (u.ks >= 0) {
                float* pp = PART + ((size_t)u.ks * tl_rows + (u.pm - tl_pm0) * 256 + wr * 64 + fr) * DM + col0;
#pragma unroll
                for (int ai = 0; ai < 2; ++ai)
#pragma unroll
                    for (int m = 0; m < 4; ++m)
#pragma unroll
                        for (int bj = 0; bj < 2; ++bj)
#pragma unroll
                            for (int n = 0; n < 2; ++n) *(f32x4*)(pp + (size_t)(ai * 128 + m * 16) * DM + bj * 128 + n * 16) = acc[ai][bj][m][n];
            } else {
#pragma unroll
                for (int ai = 0; ai < 2; ++ai)
#pragma unroll
                    for (int m = 0; m < 4; ++m) { bf16_t* yp = Y + (size_t)(u.pm * 256 + ai * 128 + wr * 64 + m * 16 + fr) * DM + col0;
#pragma unroll
                        for (int bj = 0; bj < 2; ++bj)
#pragma unroll
                            for (int n = 0; n < 2; ++n) { const f32x4 v = acc[ai][bj][m][n]; u32x2 w; w.x = pk2(v[0], v[1]); w.y = pk2(v[2], v[3]); *(u32x2*)(yp + bj * 128 + n * 16) = w; } }
            }
        }
    }
};

struct EpiGU {
    static constexpr bool PERM = true, AFTER_DRAIN = false;
    bf16_t* ACT;
    __device__ __forceinline__ void operator()(AccRef acc, const Unit& u, int wr, int wc, int fr, int fq) const {
        { const int t_ = opaque_tid(); fr = t_ & 15; fq = (t_ >> 4) & 3; }
        const int col0 = u.pn * 128 + wc * 32 + 8 * fq;
#pragma unroll
        for (int ai = 0; ai < 2; ++ai)
#pragma unroll
            for (int m = 0; m < 4; ++m) {
                const f32x4 g0 = acc[ai][0][m][0], g1 = acc[ai][0][m][1], u0 = acc[ai][1][m][0], u1 = acc[ai][1][m][1];
                u32x4 w;
                w.x = pk2(silu_f(g0[0]) * u0[0], silu_f(g0[1]) * u0[1]); w.y = pk2(silu_f(g0[2]) * u0[2], silu_f(g0[3]) * u0[3]);
                w.z = pk2(silu_f(g1[0]) * u1[0], silu_f(g1[1]) * u1[1]); w.w = pk2(silu_f(g1[2]) * u1[2], silu_f(g1[3]) * u1[3]);
                *(u32x4*)(ACT + (size_t)(u.pm * 256 + ai * 128 + wr * 64 + m * 16 + fr) * FF + col0) = w;
            }
    }
};
}

namespace att {
constexpr int SLOTB = 24576, KOFF = 0, VOFF = 8192, ROFF = 16384, NSLOT = 4;
static_assert(NSLOT * SLOTB <= RING_BYTES, "attention LDS");
constexpr float NEG = -1.0e30f;
constexpr float THR = 8.0f;

__device__ __forceinline__ bf16x8 pack8(const f32x16& s, int b) {
    u32x4 w; w.x = pk2(s[b], s[b + 1]); w.y = pk2(s[b + 2], s[b + 3]); w.z = pk2(s[b + 4], s[b + 5]); w.w = pk2(s[b + 6], s[b + 7]);
    return __builtin_bit_cast(bf16x8, w);
}
template <int N> __device__ __forceinline__ void wait_vm() { asm volatile("s_waitcnt vmcnt(%0)" :: "n"(N) : "memory"); }

template <int DK, int DV>
__device__ __forceinline__ void attn_pass(LAS unsigned char* lds, const bf16_t* qptr, const bf16_t* kbase, int kpitch, const bf16_t* vtbase, int nt, int tlo, bool wnd, int qpos,
                                          f32x16 (&o)[DV / 32], float& m_out, float& l_out) {
    constexpr int NKS = DK / 16, NDB = DV / 32, NVOP = DV / 64, OPS = 1 + NVOP + (DK == 96 ? 1 : 0);
    const int tid = opaque_tid(), lane = tid & 63, i32 = lane & 31, hi = lane >> 5, wid = __builtin_amdgcn_readfirstlane(tid >> 6);
    const int dr = 8 * wid + (lane >> 3), dc = ((lane & 7) ^ ((dr >> 1) & 7)) * 8;
    const int kgo = dr * kpitch + dc, vgo = dr * SK + dc;
    const int rr = 8 * wid + (lane >> 2), rgo = rr * kpitch + 64 + (((lane & 3) ^ ((rr >> 2) & 3)) * 8);
    const int kap = (i32 & 0x13) | ((i32 & 4) << 1) | ((i32 & 8) >> 1);
    const int kfx = (kap >> 1) & 7, vfx = (i32 >> 1) & 7, rfx = (kap >> 2) & 3;
    bf16x8 q[NKS];
#pragma unroll
    for (int ks = 0; ks < NKS; ++ks) q[ks] = *(const bf16x8*)(qptr + 16 * ks);
#pragma unroll
    for (int db = 0; db < NDB; ++db)
#pragma unroll
        for (int r = 0; r < 16; ++r) o[db][r] = 0.f;
    float m = 0.f, l = 0.f;
    f32x16 negm;
#pragma unroll
    for (int r = 0; r < 16; ++r) negm[r] = 0.f;
#define ATT_ISSUE(t_, slot_) do { const bf16_t* kg_ = kbase + (size_t)(64 * (t_)) * kpitch; LAS unsigned char* sb_ = lds + (slot_) * SLOTB + wid * 1024; \
        __builtin_amdgcn_global_load_lds((const unsigned*)(kg_ + kgo), (LAS unsigned*)(sb_ + KOFF), 16, 0, 0); \
        _Pragma("unroll") for (int v_ = 0; v_ < NVOP; ++v_) __builtin_amdgcn_global_load_lds((const unsigned*)(vtbase + 64 * (t_) + vgo + v_ * 64 * SK), (LAS unsigned*)(sb_ + VOFF + v_ * 8192), 16, 0, 0); \
        if (DK == 96) { if (lane < 32) __builtin_amdgcn_global_load_lds((const unsigned*)(kg_ + rgo), (LAS unsigned*)(lds + (slot_) * SLOTB + ROFF + wid * 512), 16, 0, 0); } } while (0)
#define ATT_T(jj_) ((jj_) < 4 ? (jj_) : tlo + (jj_) - 4)
    ATT_ISSUE(ATT_T(0), 0);
    if (nt > 1) ATT_ISSUE(ATT_T(1), 1);
    if (nt > 2) ATT_ISSUE(ATT_T(2), 2);
    for (int jj = 0; jj < nt; ++jj) {
        const int t = ATT_T(jj);
        if (jj + 2 < nt) wait_vm<2 * OPS>(); else if (jj + 1 < nt) wait_vm<OPS>(); else wait_vm<0>();
        __builtin_amdgcn_s_barrier();
        asm volatile("" ::: "memory");
        if (jj + 3 < nt) ATT_ISSUE(ATT_T(jj + 3), (jj + 3) & 3);
        const LAS unsigned char* sb = lds + (jj & 3) * SLOTB;
        f32x16 s0 = negm, s1 = negm;
        bf16x8 kf0[NKS], kf1[NKS];
#pragma unroll
        for (int ks = 0; ks < NKS; ++ks) {
            if (ks < 4) { const LAS unsigned char* p = sb + KOFF + kap * 128 + (((2 * ks + hi) ^ kfx) * 16); kf0[ks] = *(const LAS bf16x8*)p; kf1[ks] = *(const LAS bf16x8*)(p + 4096); }
            else { const LAS unsigned char* p = sb + ROFF + kap * 64 + (((2 * (ks - 4) + hi) ^ rfx) * 16); kf0[ks] = *(const LAS bf16x8*)p; kf1[ks] = *(const LAS bf16x8*)(p + 2048); }
        }
        __builtin_amdgcn_sched_barrier(0);
        __builtin_amdgcn_s_setprio(1);
#pragma unroll
        for (int ks = 0; ks < NKS; ++ks) {
            s0 = __builtin_amdgcn_mfma_f32_32x32x16_bf16(kf0[ks], q[ks], s0, 0, 0, 0);
            s1 = __builtin_amdgcn_mfma_f32_32x32x16_bf16(kf1[ks], q[ks], s1, 0, 0, 0);
        }
        __builtin_amdgcn_s_setprio(0);
        bf16x8 vfa[8];
#pragma unroll
        for (int db = 0; db < 2; ++db)
#pragma unroll
            for (int c = 0; c < 4; ++c) vfa[db * 4 + c] = *(const LAS bf16x8*)(sb + VOFF + db * 4096 + i32 * 128 + (((2 * c + hi) ^ vfx) * 16));
        __builtin_amdgcn_sched_barrier(0);
        if (wnd && t >= 4) {
            const int d0 = qpos - (64 * t - 256 + 8 * hi);
#pragma unroll
            for (int r = 0; r < 16; ++r) { const int kidx = (r & 7) + 16 * (r >> 3); const int da = d0 - kidx, db_ = d0 - 32 - kidx;
                if (da > 128 || da < -128) s0[r] = NEG; if (db_ > 128 || db_ < -128) s1[r] = NEG; }
        }
        float mx;
        { float a0 = __builtin_fmaxf(s0[0], s0[1]), a1 = __builtin_fmaxf(s0[2], s0[3]), a2 = __builtin_fmaxf(s1[0], s1[1]), a3 = __builtin_fmaxf(s1[2], s1[3]);
#pragma unroll
          for (int r = 4; r < 16; r += 4) { a0 = __builtin_fmaxf(__builtin_fmaxf(a0, s0[r]), s0[r + 1]); a1 = __builtin_fmaxf(__builtin_fmaxf(a1, s0[r + 2]), s0[r + 3]);
              a2 = __builtin_fmaxf(__builtin_fmaxf(a2, s1[r]), s1[r + 1]); a3 = __builtin_fmaxf(__builtin_fmaxf(a3, s1[r + 2]), s1[r + 3]); }
          mx = xmax32(__builtin_fmaxf(__builtin_fmaxf(a0, a1), __builtin_fmaxf(a2, a3))); }
        if (jj == 0 || __any(mx > THR)) {
            const float dm = jj == 0 ? mx : __builtin_fmaxf(mx, 0.f);
            const float alpha = __builtin_amdgcn_exp2f(-dm);
            m += dm; l *= alpha;
#pragma unroll
            for (int r = 0; r < 16; ++r) { negm[r] = -m; s0[r] -= dm; s1[r] -= dm; }
#pragma unroll
            for (int db = 0; db < NDB; ++db)
#pragma unroll
                for (int r = 0; r < 16; ++r) o[db][r] *= alpha;
        }
        { float p0 = 0.f, p1 = 0.f, p2 = 0.f, p3 = 0.f;
#pragma unroll
          for (int r = 0; r < 16; r += 2) { s0[r] = __builtin_amdgcn_exp2f(s0[r]); s0[r + 1] = __builtin_amdgcn_exp2f(s0[r + 1]); s1[r] = __builtin_amdgcn_exp2f(s1[r]); s1[r + 1] = __builtin_amdgcn_exp2f(s1[r + 1]);
              p0 += s0[r]; p1 += s0[r + 1]; p2 += s1[r]; p3 += s1[r + 1]; }
          l += (p0 + p1) + (p2 + p3); }
        bf16x8 pf[4];
        pf[0] = pack8(s0, 0); pf[1] = pack8(s0, 8); pf[2] = pack8(s1, 0); pf[3] = pack8(s1, 8);
        __builtin_amdgcn_sched_barrier(0);
        __builtin_amdgcn_s_setprio(1);
        if constexpr (NDB == 4) {
            bf16x8 vfb[8];
#pragma unroll
            for (int db = 0; db < 2; ++db)
#pragma unroll
                for (int c = 0; c < 4; ++c) vfb[db * 4 + c] = *(const LAS bf16x8*)(sb + VOFF + (db + 2) * 4096 + i32 * 128 + (((2 * c + hi) ^ vfx) * 16));
#pragma unroll
            for (int db = 0; db < 2; ++db)
#pragma unroll
                for (int c = 0; c < 4; ++c) o[db] = __builtin_amdgcn_mfma_f32_32x32x16_bf16(vfa[db * 4 + c], pf[c], o[db], 0, 0, 0);
#pragma unroll
            for (int db = 0; db < 2; ++db)
#pragma unroll
                for (int c = 0; c < 4; ++c) o[db + 2] = __builtin_amdgcn_mfma_f32_32x32x16_bf16(vfb[db * 4 + c], pf[c], o[db + 2], 0, 0, 0);
        } else {
#pragma unroll
            for (int db = 0; db < 2; ++db)
#pragma unroll
                for (int c = 0; c < 4; ++c) o[db] = __builtin_amdgcn_mfma_f32_32x32x16_bf16(vfa[db * 4 + c], pf[c], o[db], 0, 0, 0);
        }
        __builtin_amdgcn_s_setprio(0);
        __builtin_amdgcn_sched_barrier(0);
    }
    asm volatile("s_waitcnt lgkmcnt(0)" ::: "memory");
    __builtin_amdgcn_s_barrier();
    asm volatile("" ::: "memory");
#undef ATT_ISSUE
#undef ATT_T
    m_out = m; l_out = l;
}

template <int NDB>
__device__ __forceinline__ void store_o(const f32x16 (&o)[NDB], float inv, bf16_t* orow, int hi) {
#pragma unroll
    for (int db = 0; db < NDB; ++db)
#pragma unroll
        for (int rg = 0; rg < 4; ++rg) { u32x2 w; w.x = pk2(o[db][4 * rg] * inv, o[db][4 * rg + 1] * inv); w.y = pk2(o[db][4 * rg + 2] * inv, o[db][4 * rg + 3] * inv);
            *(u32x2*)(orow + 32 * db + 8 * rg + 4 * hi) = w; }
}

struct Tensors { const bf16_t* P; const bf16_t* QC; const bf16_t* KC; const bf16_t* Vt; bf16_t* O; const float* subln; const float* sink; float lam, one_m_lam_init; };

__device__ __forceinline__ void attn_phase(LAS unsigned char* lds, const Tensors& T, int vcu, int G, int bx, bool with_ctx) {
#ifndef ATT_MASK
#define ATT_MASK 7
#endif
    if (ATT_MASK & 1) {
        const int tid = opaque_tid(), lane = tid & 63, i32 = lane & 31, hi = lane >> 5, wid = tid >> 6;
        const int nper = (256 + G - 1) / G;
        const int nctx = with_ctx ? ((bx < 16) ? (16 - bx + G - 1) / G : 0) : 0;
        for (int it = 0; it < nper + nctx; ++it) {
            int b, h, qrow0, nt;
            if (it < nper) { const int u = vcu * nper + it; if (u >= 256) continue; const int combo = u >> 4, qb = u & 15; b = combo >> 2; h = combo & 3; qrow0 = b * SK + 256 + 256 * qb; nt = 68; }
            else { const int u = bx + (it - nper) * G; b = u >> 2; h = u & 3; qrow0 = b * SK; nt = 4; }
            const int qrow = qrow0 + wid * 32 + i32;
            unsigned keep[32];
#pragma unroll 1
            for (int mp = 1; mp >= 0; --mp) {
                f32x16 o[4]; float m, l;
                attn_pass<64, 128>(lds, T.P + (size_t)qrow * PW + mp * 256 + h * 64 + 8 * hi, T.P + (size_t)(b * SK) * PW + 2304 + mp * 256 + h * 64, PW,
                                   T.Vt + ((size_t)b * VT_ROWS + h * 128) * SK, nt, 4, false, 0, o, m, l);
                l = xsum32(l);
                const float inv = 1.0f / l;
                if (mp == 1) {
#pragma unroll
                    for (int db = 0; db < 4; ++db)
#pragma unroll
                        for (int i = 0; i < 8; ++i) keep[8 * db + i] = pk2(o[db][2 * i] * inv, o[db][2 * i + 1] * inv);
                } else {
                    float ss = 0.f;
#pragma unroll
                    for (int db = 0; db < 4; ++db)
#pragma unroll
                        for (int i = 0; i < 8; ++i) { const unsigned kw = keep[8 * db + i]; const float d0 = o[db][2 * i] * inv - T.lam * bflo(kw), d1 = o[db][2 * i + 1] * inv - T.lam * bfhi(kw); o[db][2 * i] = d0; o[db][2 * i + 1] = d1; ss += d0 * d0 + d1 * d1; }
                    ss = xsum32(ss);
                    const float rs = __builtin_amdgcn_rsqf(ss * (1.0f / 128.0f) + EPS) * T.one_m_lam_init;
                    bf16_t* orow = T.O + (size_t)qrow * DM + h * 128;
#pragma unroll
                    for (int db = 0; db < 4; ++db)
#pragma unroll
                        for (int rg = 0; rg < 4; ++rg) { const int d0 = 32 * db + 8 * rg + 4 * hi; const f32x4 g = *(const f32x4*)(T.subln + d0);
                            u32x2 w; w.x = pk2(o[db][4 * rg] * rs * g[0], o[db][4 * rg + 1] * rs * g[1]); w.y = pk2(o[db][4 * rg + 2] * rs * g[2], o[db][4 * rg + 3] * rs * g[3]);
                            *(u32x2*)(orow + d0) = w; }
                }
            }
        }
    }
    if (ATT_MASK & 2) {
        const int tid = opaque_tid(), lane = tid & 63, i32 = lane & 31, hi = lane >> 5, wid = tid >> 6;
        const int nper = (512 + G - 1) / G;
        const int c0 = (bx + G - (16 % G)) % G;
        const int nctx = with_ctx ? ((c0 < 64) ? (64 - c0 + G - 1) / G : 0) : 0;
        for (int it = 0; it < 2 * nper + nctx; ++it) {
            int kind, b, head, qrow0, nt, tlo, qpos0; bool wnd;
            if (it < 2 * nper) { kind = it >= nper ? 1 : 0; const int u = vcu * nper + (it - kind * nper); if (u >= 512) continue; const int combo = u >> 6, hq = (u >> 4) & 3, qb = u & 15;
                b = combo >> 1; head = (combo & 1) * 4 + hq; qrow0 = b * SK + 256 + 256 * qb; qpos0 = 256 * qb;
                if (kind) { wnd = true; const int lo = qpos0 - 128 < 0 ? 0 : qpos0 - 128, hi_ = qpos0 + 384 > SEQ ? SEQ : qpos0 + 384; tlo = 4 + lo / 64; nt = 4 + (hi_ - lo) / 64; } else { wnd = false; tlo = 4; nt = 68; } }
            else { const int u = c0 + (it - 2 * nper) * G; kind = u >> 5; b = (u & 31) >> 3; head = u & 7; qrow0 = b * SK; nt = 4; tlo = 4; wnd = false; qpos0 = 0; }
            const int g = head >> 2;
            const int qcol = (kind ? 1792 : 512) + head * 64, kcol = (kind ? 2944 : 2816) + g * 64, vrow = (kind ? 640 : 512) + g * 64, ocol = (kind ? 1536 : 512) + head * 64;
            const int qrow = qrow0 + wid * 32 + i32;
            f32x16 o[2]; float m, l;
            attn_pass<64, 64>(lds, T.P + (size_t)qrow * PW + qcol + 8 * hi, T.P + (size_t)(b * SK) * PW + kcol, PW, T.Vt + ((size_t)b * VT_ROWS + vrow) * SK, nt, tlo, wnd, qpos0 + wid * 32 + i32, o, m, l);
            l = xsum32(l);
            if (kind) l += __builtin_amdgcn_exp2f(T.sink[head] * LOG2E - m);
            store_o<2>(o, 1.0f / l, T.O + (size_t)qrow * DM + ocol, hi);
        }
    }
    if (ATT_MASK & 4) {
        const int tid = opaque_tid(), lane = tid & 63, i32 = lane & 31, hi = lane >> 5, wid = tid >> 6;
        const int nper = (512 + G - 1) / G;
        const int c0 = (bx + G - (80 % G)) % G;
        const int nctx = with_ctx ? ((c0 < 32) ? (32 - c0 + G - 1) / G : 0) : 0;
        for (int it = 0; it < nper + nctx; ++it) {
            int b, h, qrow0, nt;
            if (it < nper) { const int u = vcu * nper + it; if (u >= 512) continue; const int combo = u >> 4, qb = u & 15; b = combo >> 3; h = combo & 7; qrow0 = b * SK + 256 + 256 * qb; nt = 68; }
            else { const int u = c0 + (it - nper) * G; b = u >> 3; h = u & 7; qrow0 = b * SK; nt = 4; }
            const int qrow = qrow0 + wid * 32 + i32;
            f32x16 o[2]; float m, l;
            attn_pass<96, 64>(lds, T.QC + (size_t)qrow * 768 + h * 96 + 8 * hi, T.KC + (size_t)(b * SK) * 768 + h * 96, 768, T.Vt + ((size_t)b * VT_ROWS + 768 + h * 64) * SK, nt, 4, false, 0, o, m, l);
            l = xsum32(l);
            store_o<2>(o, 1.0f / l, T.O + (size_t)qrow * DM + 1024 + h * 64, hi);
        }
    }
}
}

#define XB_TMO      128
#define XB_XCNT(j)  (256  + 64 * (j))
#define XB_XSUB(j)  (1280 + 64 * (j))
#define XB_XGEN(j)  (2304 + 64 * (j))
#define XB_TOP      3328
#define XB_TOPGEN   3392
#define XCD_BAR_WORDS 3456
#define XB_SPIN_CAP (1u << 18)

__device__ __forceinline__ unsigned xb_ld(unsigned* p)              { return __hip_atomic_load(p, __ATOMIC_RELAXED, __HIP_MEMORY_SCOPE_AGENT); }
__device__ __forceinline__ unsigned xb_add(unsigned* p, unsigned v) { return __hip_atomic_fetch_add(p, v, __ATOMIC_RELAXED, __HIP_MEMORY_SCOPE_AGENT); }
__device__ __forceinline__ unsigned xb_xcc_id() { return (unsigned)__builtin_amdgcn_s_getreg((3 << 11) | 20) & 0xFu; }
#define XB_SPIN(cond, bar) do { unsigned _sp = 0; while (cond) { __builtin_amdgcn_s_sleep(1); \
    if ((++_sp & 255u) == 0u) { if (xb_ld(&(bar)[XB_TMO])) break; if (_sp > XB_SPIN_CAP) { atomicAdd(&(bar)[XB_TMO], 1u); break; } } } } while (0)

struct XcdBarrier {
    unsigned* bar; unsigned x;
    volatile LAS unsigned* st;
};

__device__ __forceinline__ XcdBarrier xcd_barrier_post(unsigned* bar, volatile LAS unsigned* st) {
    XcdBarrier b; b.bar = bar; b.x = xb_xcc_id(); b.st = st;
    if (threadIdx.x == 0) (void)xb_add(&bar[XB_XCNT(b.x)], 1u);
    return b;
}
__device__ __forceinline__ void xcd_barrier_complete(unsigned* bar, unsigned x, unsigned& nloc, unsigned& nx) {
    const unsigned G = gridDim.x * gridDim.y * gridDim.z;
    unsigned sum, cnt, mine, sp = 0u;
    for (;;) {
        sum = 0u; cnt = 0u; mine = 0u;
#pragma unroll
        for (unsigned j = 0; j < 16; ++j) { const unsigned c = xb_ld(&bar[XB_XCNT(j)]); sum += c; cnt += (c > 0u) ? 1u : 0u; mine = (j == x) ? c : mine; }
        if (sum == G) break;
        __builtin_amdgcn_s_sleep(1);
        if ((++sp & 255u) == 0u) { if (xb_ld(&bar[XB_TMO])) break; if (sp > XB_SPIN_CAP) { atomicAdd(&bar[XB_TMO], 1u); break; } }
    }
    nloc = mine > 0u ? mine : 1u; nx = cnt > 0u ? cnt : 1u;
}

__device__ __forceinline__ void xcd_barrier(const XcdBarrier& b) {
    asm volatile("s_waitcnt vmcnt(0)" ::: "memory");
    __syncthreads();
    if (threadIdx.x == 0) {
        unsigned* bar = b.bar;
        __builtin_amdgcn_s_waitcnt(0);
        unsigned nloc = b.st[0], nx = b.st[1];
        if (nloc == 0u) { xcd_barrier_complete(bar, b.x, nloc, nx); b.st[0] = nloc; b.st[1] = nx; }
        const unsigned old = xb_add(&bar[XB_XSUB(b.x)], 1u);
        const unsigned gen = old / nloc;
        if (old + 1u == (gen + 1u) * nloc) {
            __builtin_amdgcn_fence(__ATOMIC_RELEASE, "agent");
            asm volatile("s_waitcnt vmcnt(0)" ::: "memory");
            const unsigned og = xb_add(&bar[XB_TOP], 1u);
            const unsigned tg = og / nx;
            if (og + 1u == (tg + 1u) * nx) xb_add(&bar[XB_TOPGEN], 1u);
            else XB_SPIN(xb_ld(&bar[XB_TOPGEN]) == tg, bar);
            __builtin_amdgcn_fence(__ATOMIC_ACQUIRE, "agent");
            xb_add(&bar[XB_XGEN(b.x)], 1u);
            asm volatile("s_waitcnt vmcnt(0)" ::: "memory");
        } else {
            XB_SPIN(xb_ld(&bar[XB_XGEN(b.x)]) == gen, bar);
            __builtin_amdgcn_fence(__ATOMIC_ACQUIRE, "agent");
            asm volatile("s_waitcnt vmcnt(0)" ::: "memory");
        }
    }
    __syncthreads();
}


__device__ __forceinline__ void p0_transpose_item(const float* W, int K, int N, bf16_t* WT, int k0, int n0, int drow0, LAS float* scr, int lane) {
#pragma unroll 8
    for (int i = 0; i < 32; ++i) { const int kk = 2 * i + (lane >> 5); scr[kk * 33 + (lane & 31)] = W[(size_t)(k0 + kk) * N + n0 + (lane & 31)]; }
    LDS_WAIT(); asm volatile("" ::: "memory");
    const int c = lane & 7;
#pragma unroll
    for (int j = 0; j < 4; ++j) { const int n = (lane >> 3) + 8 * j; const LAS float* s = scr + (8 * c) * 33 + n;
        u32x4 o; o.x = pk2(s[0 * 33], s[1 * 33]); o.y = pk2(s[2 * 33], s[3 * 33]); o.z = pk2(s[4 * 33], s[5 * 33]); o.w = pk2(s[6 * 33], s[7 * 33]);
        *(GAS u32x4*)(WT + (size_t)(drow0 + n) * K + k0 + 8 * c) = o; }
    LDS_WAIT(); asm volatile("" ::: "memory");
}
__device__ __forceinline__ int map_in(int n0) {
    if (n0 < 2816) return n0;
    if (n0 < 3328) return n0 + 512;
    if (n0 < 3456) return n0 - 512;
    if (n0 < 3584) return n0 + 384;
    if (n0 < 3840) return n0 - 512;
    if (n0 < 3872) return n0 + 256;
    if (n0 < 4000) return n0 - 928;
    return n0 - 32;
}
__device__ __forceinline__ int map_kv(int n0) { const int h = n0 >> 7, j = n0 & 127; return j < 64 ? h * 64 + j : 512 + h * 64 + (j - 64); }
__device__ __forceinline__ int map_gate(int n0) { return (n0 >> 7) * 256 + (n0 & 127); }

__device__ __forceinline__ void dsincos(double x, double& s, double& c) {
    const double TWO_PI = 6.283185307179586476925286766559;
    const double k = __builtin_floor(x / TWO_PI + 0.5);
    const double y = x - k * TWO_PI, y2 = y * y;
    double ts = y, tc = 1.0; s = y; c = 1.0;
    for (int n = 1; n <= 16; ++n) { tc = -tc * y2 / (double)((2 * n - 1) * (2 * n)); ts = -ts * y2 / (double)((2 * n) * (2 * n + 1)); c += tc; s += ts; }
}
struct Args { const float* in[31]; float* out; unsigned char* ws; int ph_lo, ph_hi, rep_mask, pad; };
static_assert(sizeof(Args) == 31 * 8 + 8 + 8 + 16, "Args has no padding");
typedef Args Ptrs;

__device__ __forceinline__ void p0_prologue(const Ptrs& A, LAS unsigned char* lds, int vcu, int G) {
    const int tid = opaque_tid(), lane = tid & 63, wave = tid >> 6;
    float* cst = (float*)(A.ws + WS_CONST);
    {
        LAS float* sl = (LAS float*)lds;
        LAS float* red = (LAS float*)(lds + 5 * 2048 * 4);
        for (int i = tid; i < 5 * 2048; i += 512) { const int v = i >> 11, k = i & 2047; const float x = v < 4 ? A.in[1][v * 2048 + k] : A.in[3][k]; sl[i] = x / (1.0f + __expf(-x)); }
        __syncthreads();
        for (int item = vcu; item < 2 * 192; item += G) {
            const int l = item / 192, n0 = (item % 192) * 64;
            const float* W = A.in[4] + (size_t)l * 2048 * 12288 + n0 + lane;
            float a0 = 0.f, a1 = 0.f, a2 = 0.f, a3 = 0.f, a4 = 0.f;
#pragma unroll 8
            for (int kk = 0; kk < 256; ++kk) { const int k = wave * 256 + kk; const float w = W[(size_t)k * 12288];
                a0 += sl[k] * w; a1 += sl[2048 + k] * w; a2 += sl[4096 + k] * w; a3 += sl[6144 + k] * w; a4 += sl[8192 + k] * w; }
            red[(wave * 5 + 0) * 64 + lane] = a0; red[(wave * 5 + 1) * 64 + lane] = a1; red[(wave * 5 + 2) * 64 + lane] = a2; red[(wave * 5 + 3) * 64 + lane] = a3; red[(wave * 5 + 4) * 64 + lane] = a4;
            __syncthreads();
            if (tid < 320) { const int v = tid >> 6, n = tid & 63; float s = A.in[5][l * 12288 + n0 + n];
#pragma unroll
                for (int w = 0; w < 8; ++w) s += red[(w * 5 + v) * 64 + n];
                cst[CO_MOD + (l * 5 + v) * 12288 + n0 + n] = s; }
            __syncthreads();
        }
    }
    if (blockIdx.x == 0) {
        if (tid < 24) {
            const bool mla = tid >= 16; const int f = mla ? tid - 16 : tid;
            const double r = mla ? 0.31622776601683794 : 0.5623413251903491;
            double inv = 1.0; for (int i = 0; i < f; ++i) inv *= r;
            const float invf = (float)inv;
            for (int pos = 0; pos < 64; ++pos) { double s, c; dsincos((double)((float)pos * invf), s, c);
                if (mla) { cst[CO_ROPEM + pos * 8 + f] = (float)c; cst[CO_ROPEM + 512 + pos * 8 + f] = (float)s; }
                else { cst[CO_ROPEH + pos * 16 + f] = (float)c; cst[CO_ROPEH + 1024 + pos * 16 + f] = (float)s; } }
        }
        if (tid >= 64 && tid < 66) { const int l = tid - 64; float s1 = 0.f, s2 = 0.f;
            for (int i = 0; i < 64; ++i) { s1 += A.in[11][l * 64 + i] * A.in[12][l * 64 + i]; s2 += A.in[13][l * 64 + i] * A.in[14][l * 64 + i]; }
            const float lam_init = l == 0 ? 0.2f : 0.35550906759096926f;
            cst[CO_LAM + l] = __expf(s1) - __expf(s2) + lam_init; }
    }
    {
        LAS float* scr = (LAS float*)lds + wave * (64 * 33);
        static_assert(8 * 64 * 33 * 4 <= RING_BYTES, "transpose scratch");
        const int gw = vcu * 8 + wave, NGW = G * 8;
        bf16_t* Win = (bf16_t*)(A.ws + WS_WIN); bf16_t* Wout = (bf16_t*)(A.ws + WS_WOUT); bf16_t* Wq = (bf16_t*)(A.ws + WS_WQUP); bf16_t* Wkv = (bf16_t*)(A.ws + WS_WKVUP);
        bf16_t* Wgu0 = (bf16_t*)(A.ws + WS_WGU0); bf16_t* Wdn0 = (bf16_t*)(A.ws + WS_WDN0); bf16_t* Wgu1 = (bf16_t*)(A.ws + WS_WGU1); bf16_t* Wdn1 = (bf16_t*)(A.ws + WS_WDN1);
        constexpr int I_IN = 32 * 129, I_OUT = 32 * 64, I_Q = 12 * 24, I_KV = 4 * 32, I_G = 32 * 176, I_D = 88 * 64;
        constexpr int S0 = 2 * I_IN, S1 = S0 + 2 * I_OUT, S2 = S1 + 2 * I_Q, S3 = S2 + 2 * I_KV, S4 = S3 + 9 * 3 * I_G;
        static_assert(I_G == I_D, "items");
        for (int it = gw; it < S4; it += NGW) {
            if (it < S0) { const int l = it / I_IN, r = it % I_IN, kb = r / 129, nb = r % 129; p0_transpose_item(A.in[9] + (size_t)l * 2048 * IN_SRC, 2048, IN_SRC, Win + (size_t)l * INW * 2048, 64 * kb, 32 * nb, map_in(32 * nb), scr, lane); }
            else if (it < S1) { const int q = it - S0, l = q / I_OUT, r = q % I_OUT, kb = r / 64, nb = r % 64; p0_transpose_item(A.in[10] + (size_t)l * 2048 * 2048, 2048, 2048, Wout + (size_t)l * 2048 * 2048, 64 * kb, 32 * nb, 32 * nb, scr, lane); }
            else if (it < S2) { const int q = it - S1, l = q / I_Q, r = q % I_Q, kb = r / 24, nb = r % 24; p0_transpose_item(A.in[20] + (size_t)l * 768 * 768, 768, 768, Wq + (size_t)l * 768 * 768, 64 * kb, 32 * nb, 32 * nb, scr, lane); }
            else if (it < S3) { const int q = it - S2, l = q / I_KV, r = q % I_KV, kb = r / 32, nb = r % 32; p0_transpose_item(A.in[21] + (size_t)l * 256 * 1024, 256, 1024, Wkv + (size_t)l * 1024 * 256, 64 * kb, 32 * nb, map_kv(32 * nb), scr, lane); }
            else { const int q = it - S3, j = q / (3 * I_G), r3 = q % (3 * I_G), which = r3 / I_G, r = r3 % I_G;
                if (which < 2) { const int kb = r / 176, nb = r % 176;
                    const float* src = j == 0 ? (which == 0 ? A.in[23] : A.in[24]) : (which == 0 ? A.in[28] : A.in[29]) + (size_t)(j - 1) * 2048 * FF;
                    bf16_t* dst = j == 0 ? Wgu0 : Wgu1 + (size_t)(j - 1) * 11264 * 2048;
                    p0_transpose_item(src, 2048, FF, dst, 64 * kb, 32 * nb, map_gate(32 * nb) + which * 128, scr, lane); }
                else { const int kb = r / 64, nb = r % 64;
                    const float* src = j == 0 ? A.in[25] : A.in[30] + (size_t)(j - 1) * FF * 2048;
                    bf16_t* dst = j == 0 ? Wdn0 : Wdn1 + (size_t)(j - 1) * 2048 * FF;
                    p0_transpose_item(src, FF, 2048, dst, 64 * kb, 32 * nb, 32 * nb, scr, lane); } }
        }
        for (int i = gw * 64 + lane; i < 2 * 224 * 256; i += NGW * 64) { const int l = i / (224 * 256), r = i % (224 * 256);
            *(GAS u32x4*)(Win + ((size_t)l * INW + 4128) * 2048 + (size_t)r * 8) = (u32x4){0u, 0u, 0u, 0u}; }
    }
}

__device__ __forceinline__ void norm_phase(const Ptrs& A, int l, int which, bool route, bool lat_in, int cmode, int vcu, int G) {
    const int tid = opaque_tid(), lane = tid & 63, wave = tid >> 6;
    float* H = (float*)(A.ws + WS_H); bf16_t* U = (bf16_t*)(A.ws + WS_U); const float* PART = (const float*)(A.ws + WS_PART);
    const float* MOD = (const float*)(A.ws + WS_CONST) + CO_MOD + (size_t)l * 5 * 12288 + which * 3 * 2048;
    const float* gain = (which ? A.in[7] : A.in[6]) + l * 2048;
    unsigned* ctl = (unsigned*)(A.ws + WS_CTL); int* rt = (int*)(A.ws + WS_ROUTE);
    const int gw = vcu * 8 + wave, NGW = G * 8, nrows = route ? NLAT : MR;
    for (int i = gw; i < nrows; i += NGW) {
        const int r = route ? (i / SEQ) * SK + CTXL + (i % SEQ) : i;
        const int b = r / SK, kk = r % SK; const bool isctx = kk < CTXL; const int modv = isctx ? 4 : b;
        const float* sh = MOD + (size_t)modv * 12288; const float* sc = sh + 2048;
        const float* xsrc = isctx ? ((cmode == 1 || cmode == 2) ? A.in[2] + ((size_t)b * CTXL + kk) * DM : H + (size_t)r * DM)
                                  : (lat_in ? A.in[0] + ((size_t)b * SEQ + kk - CTXL) * DM : H + (size_t)r * DM);
        const GAS f32x4* xr = (const GAS f32x4*)xsrc + lane;
        f32x4 v[8]; float ss = 0.f;
#pragma unroll
        for (int j = 0; j < 8; ++j) v[j] = xr[64 * j];
        if (isctx && cmode >= 2) {
            const GAS f32x4* pr = (const GAS f32x4*)(PART + (size_t)(b * 256 + kk) * DM) + lane;
#pragma unroll
            for (int k = 0; k < 8; ++k)
#pragma unroll
                for (int j = 0; j < 8; ++j) v[j] = v[j] + pr[(size_t)k * 1024 * (DM / 4) + 64 * j];
            GAS f32x4* hw = (GAS f32x4*)(H + (size_t)r * DM) + lane;
#pragma unroll
            for (int j = 0; j < 8; ++j) hw[64 * j] = v[j];
        }
#pragma unroll
        for (int j = 0; j < 8; ++j) ss += (v[j].x * v[j].x + v[j].y * v[j].y) + (v[j].z * v[j].z + v[j].w * v[j].w);
        const float rstd = 1.0f / sqrtf(wave_sum(ss, lane) * (1.0f / DM) + EPS);
        GAS u32x2* o8 = (GAS u32x2*)(U + (size_t)r * DM) + lane;
#pragma unroll
        for (int j = 0; j < 8; ++j) { const int c = 4 * lane + 256 * j; const f32x4 g4 = *(const f32x4*)(gain + c), s4 = *(const f32x4*)(sc + c), h4 = *(const f32x4*)(sh + c);
            v[j] = (v[j] * rstd * g4) * (1.0f + s4) + h4;
            u32x2 w; w.x = pk2(v[j].x, v[j].y); w.y = pk2(v[j].z, v[j].w); o8[64 * j] = w; }
        if (route) {
            const float* wr = A.in[26];
            float lg[8];
#pragma unroll
            for (int e = 0; e < 8; ++e) lg[e] = 0.f;
#pragma unroll
            for (int j = 0; j < 8; ++j)
#pragma unroll
                for (int ii = 0; ii < 4; ++ii) { const int k = 4 * lane + 256 * j + ii; const f32x4 w0 = *(const f32x4*)(wr + k * 8), w1 = *(const f32x4*)(wr + k * 8 + 4); const float x = v[j][ii];
                    lg[0] += x * w0.x; lg[1] += x * w0.y; lg[2] += x * w0.z; lg[3] += x * w0.w; lg[4] += x * w1.x; lg[5] += x * w1.y; lg[6] += x * w1.z; lg[7] += x * w1.w; }
#pragma unroll
            for (int e = 0; e < 8; ++e) lg[e] = wave_sum(lg[e], lane) + A.in[27][e];
            if (lane == 0) {
                int e0 = 0; float v0 = lg[0];
#pragma unroll
                for (int e = 1; e < 8; ++e) if (lg[e] > v0) { v0 = lg[e]; e0 = e; }
                int e1 = -1; float v1 = -3.0e38f;
#pragma unroll
                for (int e = 0; e < 8; ++e) if (e != e0 && lg[e] > v1) { v1 = lg[e]; e1 = e; }
                const float ex = __expf(v1 - v0), w0 = 1.0f / (1.0f + ex), w1 = ex / (1.0f + ex);
                const int s0 = (int)__hip_atomic_fetch_add(ctl + CW_MOE + 64 * e0, 1u, __ATOMIC_RELAXED, __HIP_MEMORY_SCOPE_AGENT);
                const int s1 = (int)__hip_atomic_fetch_add(ctl + CW_MOE + 64 * e1, 1u, __ATOMIC_RELAXED, __HIP_MEMORY_SCOPE_AGENT);
                rt[RO_E + i] = e0; rt[RO_E + NLAT + i] = e1; rt[RO_SLOT + i] = s0; rt[RO_SLOT + NLAT + i] = s1;
                ((float*)rt)[RO_GATE + i] = w0; ((float*)rt)[RO_GATE + NLAT + i] = w1;
            }
        }
    }
}

__device__ __forceinline__ void post_phase(const Ptrs& A, int l, int vcu, int G) {
    const int tid = opaque_tid(), lane = tid & 63, wave = tid >> 6;
    bf16_t* P = (bf16_t*)(A.ws + WS_P); bf16_t* KC = (bf16_t*)(A.ws + WS_KC);
    const float* cst = (const float*)(A.ws + WS_CONST);
    const float* RH = cst + CO_ROPEH; const float* RM = cst + CO_ROPEM;
    const float* qn = A.in[16] + l * 64; const float* kn = A.in[17] + l * 64; const float* cqn = A.in[18] + l * 768; const float* ckn = A.in[19] + l * 256;
    const int gw = vcu * 8 + wave, NGW = G * 8;
    int hcol; bool donorm = false, isq = false; const float* gptr = qn;
    if (lane < 8) { hcol = lane * 64; isq = true; }
    else if (lane < 16) { hcol = 512 + (lane - 8) * 64; isq = true; donorm = true; }
    else if (lane < 24) { hcol = 1792 + (lane - 16) * 64; isq = true; }
    else if (lane < 32) { hcol = 2304 + (lane - 24) * 64; }
    else if (lane < 34) { hcol = 2816 + (lane - 32) * 64; donorm = true; gptr = kn; }
    else { hcol = 2944 + ((lane - 34) & 1) * 64; }
    for (int r = gw; r < MR; r += NGW) {
        const int kk = r % SK; const bool lat = kk >= CTXL; const int t = lat ? kk - CTXL : 0, rpos = t >> 6, cpos = t & 63;
        bf16_t* Pr = P + (size_t)r * PW;
        if (lane < 36) {
            float x[64];
            { const u32x4* src = (const u32x4*)(Pr + hcol);
#pragma unroll
              for (int c = 0; c < 8; ++c) { const u32x4 w = src[c]; x[8 * c] = bflo(w.x); x[8 * c + 1] = bfhi(w.x); x[8 * c + 2] = bflo(w.y); x[8 * c + 3] = bfhi(w.y); x[8 * c + 4] = bflo(w.z); x[8 * c + 5] = bfhi(w.z); x[8 * c + 6] = bflo(w.w); x[8 * c + 7] = bfhi(w.w); } }
            if (donorm) { float ss = 0.f;
#pragma unroll
                for (int i = 0; i < 64; ++i) ss += x[i] * x[i];
                const float rstd = 1.0f / sqrtf(ss * (1.0f / 64.0f) + EPS);
#pragma unroll
                for (int i = 0; i < 64; ++i) x[i] = x[i] * rstd * gptr[i]; }
            if (lat) {
#pragma unroll
                for (int hf = 0; hf < 2; ++hf) { const int pos = hf ? cpos : rpos;
#pragma unroll
                    for (int i = 0; i < 16; ++i) { const float c = RH[pos * 16 + i], s = RH[1024 + pos * 16 + i]; const float x1 = x[32 * hf + i], x2 = x[32 * hf + 16 + i];
                        x[32 * hf + i] = x1 * c - x2 * s; x[32 * hf + 16 + i] = x2 * c + x1 * s; } }
            }
            const float sc = isq ? QS64 : 1.0f;
            { u32x4* dst = (u32x4*)(Pr + hcol);
#pragma unroll
              for (int c = 0; c < 8; ++c) { u32x4 w; w.x = pk2(x[8 * c] * sc, x[8 * c + 1] * sc); w.y = pk2(x[8 * c + 2] * sc, x[8 * c + 3] * sc); w.z = pk2(x[8 * c + 4] * sc, x[8 * c + 5] * sc); w.w = pk2(x[8 * c + 6] * sc, x[8 * c + 7] * sc); dst[c] = w; } }
        }
        { u32x2* p = (u32x2*)(Pr + 1024 + 12 * lane); float x[12];
#pragma unroll
          for (int c = 0; c < 3; ++c) { const u32x2 w = p[c]; x[4 * c] = bflo(w.x); x[4 * c + 1] = bfhi(w.x); x[4 * c + 2] = bflo(w.y); x[4 * c + 3] = bfhi(w.y); }
          float ss = 0.f;
#pragma unroll
          for (int i = 0; i < 12; ++i) ss += x[i] * x[i];
          const float rstd = 1.0f / sqrtf(wave_sum(ss, lane) * (1.0f / 768.0f) + EPS);
#pragma unroll
          for (int c = 0; c < 3; ++c) { const float* g = cqn + 12 * lane + 4 * c; u32x2 w; w.x = pk2(x[4 * c] * rstd * g[0], x[4 * c + 1] * rstd * g[1]); w.y = pk2(x[4 * c + 2] * rstd * g[2], x[4 * c + 3] * rstd * g[3]); p[c] = w; } }
        { u32x2* p = (u32x2*)(Pr + 3072 + 4 * lane); const u32x2 w = p[0]; float x0 = bflo(w.x), x1 = bfhi(w.x), x2 = bflo(w.y), x3 = bfhi(w.y);
          const float rstd = 1.0f / sqrtf(wave_sum(x0 * x0 + x1 * x1 + x2 * x2 + x3 * x3, lane) * (1.0f / 256.0f) + EPS);
          const float* g = ckn + 4 * lane; u32x2 o; o.x = pk2(x0 * rstd * g[0], x1 * rstd * g[1]); o.y = pk2(x2 * rstd * g[2], x3 * rstd * g[3]); p[0] = o; }
        { float x[32]; const u32x4* src = (const u32x4*)(Pr + 3328);
#pragma unroll
          for (int c = 0; c < 4; ++c) { const u32x4 w = src[c]; x[8 * c] = bflo(w.x); x[8 * c + 1] = bfhi(w.x); x[8 * c + 2] = bflo(w.y); x[8 * c + 3] = bfhi(w.y); x[8 * c + 4] = bflo(w.z); x[8 * c + 5] = bfhi(w.z); x[8 * c + 6] = bflo(w.w); x[8 * c + 7] = bfhi(w.w); }
          if (lat) {
#pragma unroll
              for (int hf = 0; hf < 2; ++hf) { const int pos = hf ? cpos : rpos;
#pragma unroll
                  for (int i = 0; i < 8; ++i) { const float c = RM[pos * 8 + i], s = RM[512 + pos * 8 + i]; const float x1 = x[16 * hf + i], x2 = x[16 * hf + 8 + i];
                      x[16 * hf + i] = x1 * c - x2 * s; x[16 * hf + 8 + i] = x2 * c + x1 * s; } }
          }
          if (lane < 8) { u32x4* dst = (u32x4*)(KC + (size_t)r * 768 + lane * 96 + 64);
#pragma unroll
              for (int c = 0; c < 4; ++c) { u32x4 w; w.x = pk2(x[8 * c], x[8 * c + 1]); w.y = pk2(x[8 * c + 2], x[8 * c + 3]); w.z = pk2(x[8 * c + 4], x[8 * c + 5]); w.w = pk2(x[8 * c + 6], x[8 * c + 7]); dst[c] = w; } } }
    }
}

__device__ __forceinline__ void moe_epan(const Ptrs& A, volatile LAS int* epan) {
    if (threadIdx.x == 0) { unsigned* ctl = (unsigned*)(A.ws + WS_CTL); int acc = 0; epan[0] = 0;
        for (int e = 0; e < 8; ++e) { const unsigned c = __hip_atomic_load(ctl + CW_MOE + 64 * e, __ATOMIC_RELAXED, __HIP_MEMORY_SCOPE_AGENT); acc += (int)((c + 255u) >> 8); epan[e + 1] = acc; } }
    __syncthreads();
}
__device__ __forceinline__ void scatter_phase(const Ptrs& A, volatile LAS int* epan, int vcu, int G) {
    const int tid = opaque_tid(), lane = tid & 63, wave = tid >> 6;
    const bf16_t* U = (const bf16_t*)(A.ws + WS_U); bf16_t* U2S = (bf16_t*)(A.ws + WS_U2S); int* rt = (int*)(A.ws + WS_ROUTE);
    const int gw = vcu * 8 + wave, NGW = G * 8;
    for (int i = gw; i < NLAT; i += NGW) {
        const int r = (i / SEQ) * SK + CTXL + (i % SEQ);
        const GAS u32x4* src = (const GAS u32x4*)(U + (size_t)r * DM) + lane;
        u32x4 v[4];
#pragma unroll
        for (int j = 0; j < 4; ++j) v[j] = src[64 * j];
#pragma unroll
        for (int k = 0; k < 2; ++k) { const int e = rt[RO_E + k * NLAT + i], slot = rt[RO_SLOT + k * NLAT + i]; const int dest = epan[e] * 256 + slot;
            GAS u32x4* dst = (GAS u32x4*)(U2S + (size_t)dest * DM) + lane;
#pragma unroll
            for (int j = 0; j < 4; ++j) dst[64 * j] = v[j];
            if (lane == 0) rt[RO_POS + k * NLAT + i] = dest; }
    }
}
__device__ __forceinline__ void moe_tail(int NP, int G, int& NT, int& S) {
    NT = (G % 8 == 0) ? NP % (G / 8) : 0;
    const int cap = NT > 0 ? G / (8 * NT) : 0;
    S = cap >= 8 ? 8 : cap >= 4 ? 4 : cap >= 2 ? 2 : 1;
    if (S == 1) NT = 0;
}
__device__ __forceinline__ void y_row(const bf16_t* Y, const float* PART, int p, int tail_row0, int tl_rows, int S, int lane, f32x4 (&y)[8]) {
    if (p >= tail_row0) {
        const GAS f32x4* pr = (const GAS f32x4*)(PART + (size_t)(p - tail_row0) * DM) + lane;
#pragma unroll
        for (int j = 0; j < 8; ++j) y[j] = pr[64 * j];
        for (int k = 1; k < S; ++k)
#pragma unroll
            for (int j = 0; j < 8; ++j) y[j] = y[j] + pr[(size_t)k * tl_rows * (DM / 4) + 64 * j];
    } else {
        const GAS u32x2* yr = (const GAS u32x2*)(Y + (size_t)p * DM) + lane;
#pragma unroll
        for (int j = 0; j < 8; ++j) { const u32x2 a = yr[64 * j]; y[j].x = bflo(a.x); y[j].y = bfhi(a.x); y[j].z = bflo(a.y); y[j].w = bfhi(a.y); }
    }
}
__device__ __forceinline__ void final_phase(const Ptrs& A, volatile LAS int* epan, int vcu, int G) {
    const int tid = opaque_tid(), lane = tid & 63, wave = tid >> 6;
    const float* H = (const float*)(A.ws + WS_H); const bf16_t* Y = (const bf16_t*)(A.ws + WS_Y); const float* PART = (const float*)(A.ws + WS_PART); const int* rt = (const int*)(A.ws + WS_ROUTE);
    const float* MOD = (const float*)(A.ws + WS_CONST) + CO_MOD + (size_t)1 * 5 * 12288 + 5 * 2048;
    const float* gf = A.in[8];
    int NT, S; const int NP = epan[8]; moe_tail(NP, G, NT, S);
    const int tail_row0 = NT > 0 ? (NP - NT) * 256 : 0x7fffffff, tl_rows = NT * 256;
    const int gw = vcu * 8 + wave, NGW = G * 8;
    for (int i = gw; i < NLAT; i += NGW) {
        const int b = i / SEQ, r = b * SK + CTXL + (i % SEQ);
        const int p0 = rt[RO_POS + i], p1 = rt[RO_POS + NLAT + i]; const float g0 = ((const float*)rt)[RO_GATE + i], g1 = ((const float*)rt)[RO_GATE + NLAT + i];
        const GAS f32x4* hr = (const GAS f32x4*)(H + (size_t)r * DM) + lane;
        const float* gt = MOD + (size_t)b * 12288;
        f32x4 v[8], ya[8], yb[8]; float ss = 0.f;
        y_row(Y, PART, p0, tail_row0, tl_rows, S, lane, ya);
        y_row(Y, PART, p1, tail_row0, tl_rows, S, lane, yb);
#pragma unroll
        for (int j = 0; j < 8; ++j) { const int c = 4 * lane + 256 * j; const f32x4 h4 = hr[64 * j], t4 = *(const f32x4*)(gt + c);
            v[j] = h4 + t4 * (ya[j] * g0 + yb[j] * g1);
            ss += (v[j].x * v[j].x + v[j].y * v[j].y) + (v[j].z * v[j].z + v[j].w * v[j].w); }
        const float rstd = 1.0f / sqrtf(wave_sum(ss, lane) * (1.0f / DM) + EPS);
        GAS f32x4* o = (GAS f32x4*)(A.out + (size_t)i * DM) + lane;
#pragma unroll
        for (int j = 0; j < 8; ++j) { const f32x4 g4 = *(const f32x4*)(gf + 4 * lane + 256 * j); o[64 * j] = v[j] * rstd * g4; }
    }
}

constexpr int N_PHASES = 22;
__global__ void __launch_bounds__(512, 2) fwd_kernel(Args args) {
    extern __shared__ __attribute__((aligned(16))) unsigned char lds_raw[];
    LAS unsigned char* lds = (LAS unsigned char*)lds_raw;
    volatile LAS unsigned* MISC = (volatile LAS unsigned*)(lds + MISC_OFF);
    volatile LAS int* epan = (volatile LAS int*)(lds + MISC_OFF + 64);
    const int tid = opaque_tid();
    const int G = gridDim.x, bx = blockIdx.x;
    const int vcu = (G % 8 == 0) ? (bx % 8) * (G / 8) + bx / 8 : bx;
    const Args& A = args;
    for (int u = tid; u < (LDS_BYTES - LDSCTL_OFF) / 4; u += 512) ((LAS unsigned*)(lds + LDSCTL_OFF))[u] = 0u;
    __syncthreads();
    const int lo = args.ph_lo, hi = args.ph_hi;
    unsigned* ctl = (unsigned*)(args.ws + WS_CTL);
    XcdBarrier bar; bar.bar = ctl + CW_BAR; bar.x = 0; bar.st = nullptr;
    const bool use_bar = (hi - lo) > 1;
    if (use_bar) bar = xcd_barrier_post(ctl + CW_BAR, MISC + 8);
#ifndef PHASE_MASK
#define PHASE_MASK 0xFFFu
#endif
#define EN(j) (((PHASE_MASK) >> (j)) & 1u)
#ifndef REP_MASK
#define REP_MASK 0u
#endif
#define NREP(j) (1 + ((args.rep_mask >> (j)) & 1))
#define IN(k) (lo <= (k) && (k) < hi)
#define SEAM(k) do { if (IN((k) + 1)) xcd_barrier(bar); } while (0)

    if (EN(0) && IN(0)) {
_Pragma("nounroll") for (int rep = 0; rep < NREP(0); ++rep) { p0_prologue(A, lds, vcu, G); __syncthreads(); }
        SEAM(0); }

#define WSP(T, off) ((T*)(opaque_ws(args.ws) + (off)))

    for (int l = 0; l < 2; ++l) {
        const int pb = 1 + 10 * l;
        if (EN(1) && IN(pb + 0)) {
_Pragma("nounroll") for (int rep = 0; rep < NREP(1); ++rep) norm_phase(A, l, 0, false, l == 0, l == 0 ? 1 : 3, vcu, G);
            SEAM(pb + 0); }
        if (EN(2) && IN(pb + 1)) {
            const bf16_t* Wl = (const bf16_t*)(opaque_ws(args.ws) + WS_WIN) + (size_t)l * INW * 2048; const bf16_t* Ub = WSP(const bf16_t, WS_U);
            pg8::Gemm g{Ub, Wl, Wl + (size_t)13 * 256 * 2048, Ub, DM, DM};
            pg8::Sched S; S.init(NPANEL, 14, DM / 64, G, bx, 0, nullptr, 1, 3, 3 * NPANEL);
            epi::EpiInProj E{WSP(bf16_t, WS_P), WSP(bf16_t, WS_VT)};
_Pragma("nounroll") for (int rep = 0; rep < NREP(2); ++rep)
            pg8::gemm_phase<epi::EpiInProj, pg8::Sched, true, true>(lds, g, S, E);
            SEAM(pb + 1);
        }
        if (EN(3) && IN(pb + 2)) { post_phase(A, l, vcu, G); SEAM(pb + 2); }
        if (EN(4) && IN(pb + 3)) {
_Pragma("nounroll") for (int rep = 0; rep < NREP(4); ++rep) {
#ifndef MLA_MASK
#define MLA_MASK 3
#endif
            if (MLA_MASK & 1) { pg8::Gemm g{WSP(bf16_t, WS_P) + 1024, (const bf16_t*)(opaque_ws(args.ws) + WS_WQUP) + (size_t)l * 768 * 768, nullptr, nullptr, PW, 768};
              pg8::Sched S; S.init(l == 0 ? NPANEL : 64, 3, 768 / 64, G, bx, l == 0 ? 0 : 1, nullptr);
              epi::EpiQup E{WSP(bf16_t, WS_QC), WSP(const float, WS_CONST) + CO_ROPEM, QS96};
              pg8::gemm_phase<epi::EpiQup, pg8::Sched, true, true>(lds, g, S, E); }
            __syncthreads();
            if (MLA_MASK & 2) { pg8::Gemm g{WSP(bf16_t, WS_P) + 3072, (const bf16_t*)(opaque_ws(args.ws) + WS_WKVUP) + (size_t)l * 1024 * 256, nullptr, nullptr, PW, 256};
              pg8::Sched S; S.init(NPANEL, 2, 256 / 64, G, (bx + 128) % G, 0, nullptr);
              epi::EpiKC E{WSP(bf16_t, WS_KC)};
              pg8::gemm_phase<epi::EpiKC, pg8::Sched, true, true>(lds, g, S, E); }
            __syncthreads();
            if (MLA_MASK & 2) { pg8::Gemm g{(const bf16_t*)(opaque_ws(args.ws) + WS_WKVUP) + (size_t)l * 1024 * 256 + 512 * 256, WSP(bf16_t, WS_P) + 3072, nullptr, nullptr, 256, PW};
              pg8::Sched S; S.init(2, NPANEL, 256 / 64, G, bx, 0, nullptr);
              epi::EpiVt E{WSP(bf16_t, WS_VT), 768};
              pg8::gemm_phase<epi::EpiVt, pg8::Sched, true, true>(lds, g, S, E); }
            __syncthreads(); }
            SEAM(pb + 3);
        }
        if (EN(5) && IN(pb + 4)) {
            att::Tensors T{WSP(bf16_t, WS_P), WSP(bf16_t, WS_QC), WSP(bf16_t, WS_KC), WSP(bf16_t, WS_VT), WSP(bf16_t, WS_O), A.in[15] + l * 128, A.in[22] + l * 8, WSP(const float, WS_CONST)[CO_LAM + l], l == 0 ? 0.8f : (1.0f - 0.35550906759096926f)};
_Pragma("nounroll") for (int rep = 0; rep < NREP(5); ++rep)
            att::attn_phase(lds, T, vcu, G, bx, l == 0);
            SEAM(pb + 4);
        }
        if (EN(6) && IN(pb + 5)) {
            pg8::Gemm g{WSP(bf16_t, WS_O), (const bf16_t*)(opaque_ws(args.ws) + WS_WOUT) + (size_t)l * 2048 * 2048, nullptr, nullptr, DM, DM};
            pg8::Sched S; S.init(64, 8, DM / 64, G, bx, 1, nullptr);
            if (l == 0) S.set_tail(4, 8, 0, 0);
            epi::EpiResidOrY E{WSP(float, WS_H), WSP(const float, WS_CONST) + CO_MOD + (size_t)l * 5 * 12288 + 2 * 2048, nullptr, WSP(float, WS_PART), l == 0 ? A.in[0] : nullptr, 0, 1024, 0};
            pg8::gemm_phase<epi::EpiResidOrY, pg8::Sched, true, true>(lds, g, S, E);
            SEAM(pb + 5);
        }
        if (EN(7) && IN(pb + 6)) { norm_phase(A, l, 1, l == 1, false, l == 0 ? 2 : 0, vcu, G); SEAM(pb + 6); }
        if (EN(8) && l == 1 && IN(pb + 7)) { moe_epan(A, epan);
_Pragma("nounroll") for (int rep = 0; rep < NREP(8); ++rep) scatter_phase(A, epan, vcu, G);
            SEAM(pb + 7); }
        if (EN(9) && IN(pb + 8)) {
            int npan = NPANEL;
            if (l == 1) { moe_epan(A, epan); npan = epan[8]; }
            pg8::Gemm g{l == 0 ? WSP(const bf16_t, WS_U) : WSP(const bf16_t, WS_U2S), (const bf16_t*)(opaque_ws(args.ws) + (l == 0 ? WS_WGU0 : WS_WGU1)), nullptr, nullptr, DM, DM};
            pg8::Sched S; S.init(npan, NGU_T, DM / 64, G, bx, 0, l == 0 ? nullptr : (const LAS int*)epan);
            epi::EpiGU E{WSP(bf16_t, WS_ACT)};
_Pragma("nounroll") for (int rep = 0; rep < NREP(9); ++rep)
            pg8::gemm_phase<epi::EpiGU, pg8::Sched, true, true>(lds, g, S, E);
            SEAM(pb + 8);
        }
        if (EN(10) && IN(pb + 9)) {
            int npan = NPANEL;
            if (l == 1) { moe_epan(A, epan); npan = epan[8]; }
            pg8::Gemm g{WSP(bf16_t, WS_ACT), (const bf16_t*)(opaque_ws(args.ws) + (l == 0 ? WS_WDN0 : WS_WDN1)), nullptr, nullptr, FF, FF};
            int NT = 4, TS = 8;
            if (l == 1) moe_tail(npan, G, NT, TS);
            pg8::Sched S; S.init(l == 0 ? 64 : npan - NT, 8, FF / 64, G, bx, l == 0 ? 1 : 0, l == 0 ? nullptr : (const LAS int*)epan);
            if (NT > 0) S.set_tail(NT, TS, l, npan - NT);
            epi::EpiResidOrY E{WSP(float, WS_H), WSP(const float, WS_CONST) + CO_MOD + (size_t)l * 5 * 12288 + 5 * 2048, WSP(bf16_t, WS_Y), WSP(float, WS_PART), nullptr, l, NT * 256, npan - NT};
            pg8::gemm_phase<epi::EpiResidOrY, pg8::Sched, true, true>(lds, g, S, E);
            SEAM(pb + 9);
        }
    }
    if (EN(11) && IN(21)) {
_Pragma("nounroll") for (int rep = 0; rep < NREP(11); ++rep) { moe_epan(A, epan); final_phase(A, epan, vcu, G); } }
#undef IN
#undef SEAM
}

#ifndef MK_PER_PHASE
#define MK_PER_PHASE 0
#endif
extern "C" void kernel_launch(void* const* d_in, const int* in_sizes, int n_in, void* d_out, int out_size, void* d_ws, size_t ws_size, hipStream_t stream) {
    static int grid = 0;
    if (grid == 0) {
        if (n_in != 31 || out_size != NLAT * DM || ws_size < WS_END) { fprintf(stderr, "kernel_launch: unexpected shapes (n_in %d, out %d, ws %zu < %zu); nothing launched\n", n_in, out_size, ws_size, (size_t)WS_END); grid = -1; return; }
        int dev = 0, cus = 0, per_cu = 0;
        if (hipGetDevice(&dev) != hipSuccess || hipDeviceGetAttribute(&cus, hipDeviceAttributeMultiprocessorCount, dev) != hipSuccess) { grid = -1; return; }
        if (hipFuncSetAttribute((const void*)fwd_kernel, hipFuncAttributeMaxDynamicSharedMemorySize, LDS_BYTES) != hipSuccess) { fprintf(stderr, "kernel_launch: hipFuncSetAttribute failed\n"); grid = -1; return; }
        if (hipOccupancyMaxActiveBlocksPerMultiprocessor(&per_cu, (const void*)fwd_kernel, 512, LDS_BYTES) != hipSuccess || per_cu < 1) { fprintf(stderr, "kernel_launch: occupancy query reports %d blocks per CU\n", per_cu); (void)hipGetLastError(); grid = -1; return; }
        grid = cus;
    }
    if (grid < 0) return;
    (void)hipMemsetAsync((char*)d_ws + WS_CTL, 0, CTL_ZERO_BYTES, stream);
    Args a{};
    for (int i = 0; i < 31; ++i) a.in[i] = (const float*)d_in[i];
    a.out = (float*)d_out; a.ws = (unsigned char*)d_ws; a.rep_mask = (int)(REP_MASK); a.pad = 0;
#if MK_PER_PHASE
    for (int p = 0; p < N_PHASES; ++p) { if (p == 8) continue; a.ph_lo = p; a.ph_hi = p + 1; hipLaunchKernelGGL(fwd_kernel, dim3(grid), dim3(512), LDS_BYTES, stream, a); }
#else
    a.ph_lo = 0; a.ph_hi = N_PHASES;
    hipLaunchKernelGGL(fwd_kernel, dim3(grid), dim3(512), LDS_BYTES, stream, a);
#endif
}
```
